# Optimizing an MI355X kernel written in HIP

```python
import jax, jax.numpy as jnp
from jax import lax
import numpy as np

D_MODEL = 2048
BATCH = 2
SEQ = 8192
DEPTH = 4
DEC_BATCH = 32
DEC_SEQ = 16
PAST_LEN = 1024

CHUNK = 64
Q_BLOCK = 128
HEAD_DIM = 128
N_MIX_HEADS = 12
MIX_WIDTH = N_MIX_HEADS * HEAD_DIM
N_MEM_HEADS = 4
MEM_WIDTH = N_MEM_HEADS * HEAD_DIM
BRANCH_WIDTH = MIX_WIDTH + MEM_WIDTH
N_MEM = 256
CONV_WIDTH = 4
CONV_CH = 3 * MIX_WIDTH
N_FOX = (DEPTH + 1) // 2
N_GDN = DEPTH // 2
FOX_IN = 3 * MIX_WIDTH + N_MIX_HEADS + MEM_WIDTH + BRANCH_WIDTH
GDN_IN = 3 * MIX_WIDTH + 2 * N_MIX_HEADS + MEM_WIDTH + BRANCH_WIDTH
EPS = 1e-6

kernel_name = "fox_gdn_hybrid_stream_step"


def rms_norm(x, gain):
    xf = x.astype(jnp.float32)
    y = xf * lax.rsqrt(jnp.mean(xf * xf, axis=-1, keepdims=True) + EPS)
    return (y * gain.astype(jnp.float32)).astype(x.dtype)


def l2_norm(x):
    xf = x.astype(jnp.float32)
    return xf * lax.rsqrt(jnp.sum(xf * xf, axis=-1, keepdims=True) + EPS)


def split_cols(x, sizes):
    idx = [int(s) for s in np.cumsum(sizes)[:-1]]
    return jnp.split(x, idx, axis=-1)


def memory_kv(mem, gain, w_kv):
    b = mem.shape[0]
    kv = rms_norm(mem, gain) @ w_kv
    k, v = jnp.split(kv, 2, axis=-1)
    return (k.reshape(b, N_MEM, N_MEM_HEADS, HEAD_DIM),
            v.reshape(b, N_MEM, N_MEM_HEADS, HEAD_DIM))


def mem_attend(q, k, v):
    s = jnp.einsum('bthd,bmhd->bhtm', q, k).astype(jnp.float32) * (HEAD_DIM ** -0.5)
    p = jax.nn.softmax(s, axis=-1).astype(v.dtype)
    return jnp.einsum('bhtm,bmhd->bthd', p, v)


def branch_out(mix, q_mem, z, mem_k, mem_v, w_out):
    b, T = z.shape[:2]
    qm = q_mem.reshape(b, T, N_MEM_HEADS, HEAD_DIM)
    m = mem_attend(qm, mem_k.astype(qm.dtype), mem_v.astype(qm.dtype))
    br = jnp.concatenate([mix.reshape(b, T, MIX_WIDTH).astype(z.dtype),
                          m.reshape(b, T, MEM_WIDTH).astype(z.dtype)], axis=-1) * jax.nn.silu(z)
    return br @ w_out


def fox_project(proj, b_f):
    b, T = proj.shape[:2]
    qkv, fg, q_mem, z = split_cols(proj, [3 * MIX_WIDTH, N_MIX_HEADS, MEM_WIDTH, BRANCH_WIDTH])
    q, k, v = [t.reshape(b, T, N_MIX_HEADS, HEAD_DIM) for t in jnp.split(qkv, 3, axis=-1)]
    logf = jax.nn.log_sigmoid(fg.astype(jnp.float32) + b_f.astype(jnp.float32))
    return q, k, v, logf, q_mem, z


def fox_attend(q, k, v, Fq, Fk, q_off):
    s = jnp.einsum('bqhd,bkhd->bhqk', q, k).astype(jnp.float32) * (HEAD_DIM ** -0.5)
    s = s + Fq[..., :, None] - Fk[..., None, :]
    qpos = q_off + jnp.arange(q.shape[1])
    kpos = jnp.arange(k.shape[1])
    s = jnp.where(kpos[None, :] <= qpos[:, None], s, -jnp.inf)
    p = jax.nn.softmax(s, axis=-1).astype(v.dtype)
    return jnp.einsum('bhqk,bkhd->bqhd', p, v)


def fox_prompt(q, k, v, logf):
    b, T, H, hd = q.shape
    nb = T // Q_BLOCK
    F = jnp.cumsum(logf, axis=1).transpose(0, 2, 1)
    qb = q.reshape(b, nb, Q_BLOCK, H, hd).transpose(1, 0, 2, 3, 4)
    Fb = F.reshape(b, H, nb, Q_BLOCK).transpose(2, 0, 1, 3)
    offs = jnp.arange(nb) * Q_BLOCK
    o = lax.map(lambda a: fox_attend(a[1], k, v, a[2], F, a[0]), (offs, qb, Fb))
    return o.transpose(1, 0, 2, 3, 4).reshape(b, T, H * hd)


def fox_sample(q, k, v, logf, ck, cv, clogf):
    b, L, H, hd = q.shape
    P = ck.shape[1]
    k_all = jnp.concatenate([ck.astype(k.dtype), k], axis=1)
    v_all = jnp.concatenate([cv.astype(v.dtype), v], axis=1)
    F_all = jnp.cumsum(jnp.concatenate([clogf.astype(jnp.float32), logf], axis=1), axis=1).transpose(0, 2, 1)
    o = fox_attend(q, k_all, v_all, F_all[..., P:], F_all, P)
    return o.reshape(b, L, H * hd)


def causal_conv(x, w, buf):
    T = x.shape[1]
    xp = jnp.concatenate([buf.astype(x.dtype), x], axis=1)
    y = xp[:, 0:T] * w[0]
    for j in range(1, CONV_WIDTH):
        y = y + xp[:, j:j + T] * w[j]
    return jax.nn.silu(y), xp[:, -(CONV_WIDTH - 1):]


def gdn_chunked(q, k, v, g, beta, S0, C):
    b, T, H, dk = q.shape
    dv = v.shape[-1]
    n = T // C
    blk4 = lambda t: t.reshape(b, n, C, H, t.shape[-1]).transpose(1, 0, 3, 2, 4)
    blk3 = lambda t: t.reshape(b, n, C, H).transpose(1, 0, 3, 2)
    qc, kc, vc = blk4(q), blk4(k), blk4(v)
    G = jnp.cumsum(blk3(g), axis=-1)
    bc = blk3(beta)
    tri_incl = jnp.tril(jnp.ones((C, C), bool))
    tri_strict = jnp.tril(jnp.ones((C, C), bool), -1)
    decay = jnp.exp(jnp.where(tri_incl, G[..., :, None] - G[..., None, :], -jnp.inf))
    kk = jnp.einsum('nbhid,nbhjd->nbhij', kc, kc)
    A = jnp.where(tri_strict, bc[..., :, None] * kk * decay, 0.0)
    eye = jnp.eye(C, dtype=jnp.float32)
    rhs = jnp.concatenate([vc * bc[..., None], kc * (bc * jnp.exp(G))[..., None]], axis=-1)
    sol = lax.linalg.triangular_solve(eye + A, rhs, left_side=True, lower=True, unit_diagonal=True)
    u, w = sol[..., :dv], sol[..., dv:]
    qk = jnp.where(tri_incl, jnp.einsum('nbhid,nbhjd->nbhij', qc, kc) * decay, 0.0)
    k_tail = kc * jnp.exp(G[..., -1:] - G)[..., None]
    g_last = jnp.exp(G[..., -1])
    q_dec = qc * jnp.exp(G)[..., None]

    def step(S, xs):
        u_i, w_i, qd_i, qk_i, kt_i, gl_i = xs
        v_new = u_i - jnp.einsum('bhcd,bhde->bhce', w_i, S)
        o = jnp.einsum('bhcd,bhde->bhce', qd_i, S) + jnp.einsum('bhij,bhje->bhie', qk_i, v_new)
        S = S * gl_i[..., None, None] + jnp.einsum('bhcd,bhce->bhde', kt_i, v_new)
        return S, o

    S, o = lax.scan(step, S0, (u, w, q_dec, qk, k_tail, g_last))
    return o.transpose(1, 0, 3, 2, 4).reshape(b, T, H, dv), S


def gdn_mixer(proj, conv_w, A_log, dt_bias, out_gain, S0, buf, C):
    b, T = proj.shape[:2]
    qkv, a, bt, q_mem, z = split_cols(
        proj, [3 * MIX_WIDTH, N_MIX_HEADS, N_MIX_HEADS, MEM_WIDTH, BRANCH_WIDTH])
    qkv_c, new_buf = causal_conv(qkv, conv_w, buf)
    q, k, v = [t.reshape(b, T, N_MIX_HEADS, HEAD_DIM) for t in jnp.split(qkv_c, 3, axis=-1)]
    q = l2_norm(q) * (HEAD_DIM ** -0.5)
    k = l2_norm(k)
    v = v.astype(jnp.float32)
    g = -jnp.exp(A_log.astype(jnp.float32)) * jax.nn.softplus(a.astype(jnp.float32) + dt_bias.astype(jnp.float32))
    beta = jax.nn.sigmoid(bt.astype(jnp.float32))
    o, S = gdn_chunked(q, k, v, g, beta, S0.astype(jnp.float32), C)
    o = rms_norm(o, out_gain).reshape(b, T, MIX_WIDTH)
    return o, q_mem, z, S, new_buf


def setup_inputs(seed: int = 0) -> dict:
    key = jax.random.key(seed)
    ks = jax.random.split(key, 24)
    nrm = lambda k, shape, s: jax.random.normal(k, shape, jnp.float32) * s
    H = N_MIX_HEADS
    x_prompt = nrm(ks[0], (BATCH, SEQ, D_MODEL), 1.0)
    x_sample = nrm(ks[1], (DEC_BATCH, DEC_SEQ, D_MODEL), 1.0)
    mem_prompt = nrm(ks[2], (BATCH, N_MEM, D_MODEL), 1.0)
    cache_fox_k = nrm(ks[3], (N_FOX, DEC_BATCH, PAST_LEN, H, HEAD_DIM), 1.0)
    cache_fox_v = nrm(ks[4], (N_FOX, DEC_BATCH, PAST_LEN, H, HEAD_DIM), 1.0)
    cache_fox_logf = jax.nn.log_sigmoid(
        jax.random.uniform(ks[5], (N_FOX, DEC_BATCH, PAST_LEN, H), jnp.float32, 1.0, 6.0)
        + nrm(ks[6], (N_FOX, DEC_BATCH, PAST_LEN, H), 1.0))
    state_gdn_S = nrm(ks[7], (N_GDN, DEC_BATCH, H, HEAD_DIM, HEAD_DIM), 0.1)
    state_gdn_conv = nrm(ks[8], (N_GDN, DEC_BATCH, CONV_WIDTH - 1, CONV_CH), 1.0)
    cache_mem_k = nrm(ks[9], (DEPTH, DEC_BATCH, N_MEM, N_MEM_HEADS, HEAD_DIM), 1.0)
    cache_mem_v = nrm(ks[10], (DEPTH, DEC_BATCH, N_MEM, N_MEM_HEADS, HEAD_DIM), 1.0)
    norm_gain = 1.0 + nrm(ks[11], (DEPTH, D_MODEL), 0.02)
    mem_norm_gain = 1.0 + nrm(ks[12], (DEPTH, D_MODEL), 0.02)
    w_mem_kv = nrm(ks[13], (DEPTH, D_MODEL, 2 * MEM_WIDTH), D_MODEL ** -0.5)
    w_in_fox = nrm(ks[14], (N_FOX, D_MODEL, FOX_IN), D_MODEL ** -0.5)
    b_forget = jax.random.uniform(ks[15], (N_FOX, H), jnp.float32, 1.0, 6.0)
    w_in_gdn = nrm(ks[16], (N_GDN, D_MODEL, GDN_IN), D_MODEL ** -0.5)
    gdn_conv_w = nrm(ks[17], (N_GDN, CONV_WIDTH, CONV_CH), CONV_WIDTH ** -0.5)
    gdn_A_log = jnp.log(jax.random.uniform(ks[18], (N_GDN, H), jnp.float32, 1.0, 16.0))
    dt = jnp.exp(jax.random.uniform(ks[19], (N_GDN, H), jnp.float32, np.log(1e-3), np.log(1e-1)))
    gdn_dt_bias = dt + jnp.log(-jnp.expm1(-dt))
    gdn_out_norm = 1.0 + nrm(ks[20], (N_GDN, HEAD_DIM), 0.02)
    w_out = nrm(ks[21], (DEPTH, BRANCH_WIDTH, D_MODEL), BRANCH_WIDTH ** -0.5)
    final_norm = 1.0 + nrm(ks[22], (D_MODEL,), 0.02)
    return {"x_prompt": x_prompt, "x_sample": x_sample, "mem_prompt": mem_prompt,
            "cache_fox_k": cache_fox_k, "cache_fox_v": cache_fox_v, "cache_fox_logf": cache_fox_logf,
            "state_gdn_S": state_gdn_S, "state_gdn_conv": state_gdn_conv,
            "cache_mem_k": cache_mem_k, "cache_mem_v": cache_mem_v,
            "norm_gain": norm_gain, "mem_norm_gain": mem_norm_gain, "w_mem_kv": w_mem_kv,
            "w_in_fox": w_in_fox, "b_forget": b_forget, "w_in_gdn": w_in_gdn,
            "gdn_conv_w": gdn_conv_w, "gdn_A_log": gdn_A_log, "gdn_dt_bias": gdn_dt_bias,
            "gdn_out_norm": gdn_out_norm, "w_out": w_out, "final_norm": final_norm}


def reference(x_prompt, x_sample, mem_prompt, cache_fox_k, cache_fox_v, cache_fox_logf,
              state_gdn_S, state_gdn_conv, cache_mem_k, cache_mem_v, norm_gain, mem_norm_gain,
              w_mem_kv, w_in_fox, b_forget, w_in_gdn, gdn_conv_w, gdn_A_log, gdn_dt_bias,
              gdn_out_norm, w_out, final_norm):
    xp, xs = x_prompt, x_sample
    bp, bs = xp.shape[0], xs.shape[0]
    p_k, p_v, p_lf, p_S, p_conv, p_mk, p_mv = [], [], [], [], [], [], []
    s_k, s_v, s_lf, s_S, s_conv = [], [], [], [], []
    for i in range(DEPTH):
        j = i // 2
        mk_p, mv_p = memory_kv(mem_prompt, mem_norm_gain[i], w_mem_kv[i])
        p_mk.append(mk_p)
        p_mv.append(mv_p)
        hp = rms_norm(xp, norm_gain[i])
        hs = rms_norm(xs, norm_gain[i])
        if i % 2 == 0:
            q, k, v, lf, qm_p, z_p = fox_project(hp @ w_in_fox[j], b_forget[j])
            mix_p = fox_prompt(q, k, v, lf)
            p_k.append(k); p_v.append(v); p_lf.append(lf)
            q, k, v, lf, qm_s, z_s = fox_project(hs @ w_in_fox[j], b_forget[j])
            mix_s = fox_sample(q, k, v, lf, cache_fox_k[j], cache_fox_v[j], cache_fox_logf[j])
            s_k.append(k); s_v.append(v); s_lf.append(lf)
        else:
            S0 = jnp.zeros((bp, N_MIX_HEADS, HEAD_DIM, HEAD_DIM), jnp.float32)
            buf0 = jnp.zeros((bp, CONV_WIDTH - 1, CONV_CH), xp.dtype)
            mix_p, qm_p, z_p, S, buf = gdn_mixer(hp @ w_in_gdn[j], gdn_conv_w[j], gdn_A_log[j],
                                                 gdn_dt_bias[j], gdn_out_norm[j], S0, buf0, CHUNK)
            p_S.append(S); p_conv.append(buf)
            mix_s, qm_s, z_s, S, buf = gdn_mixer(hs @ w_in_gdn[j], gdn_conv_w[j], gdn_A_log[j],
                                                 gdn_dt_bias[j], gdn_out_norm[j], state_gdn_S[j],
                                                 state_gdn_conv[j], xs.shape[1])
            s_S.append(S); s_conv.append(buf)
        xp = xp + branch_out(mix_p, qm_p, z_p, mk_p, mv_p, w_out[i])
        xs = xs + branch_out(mix_s, qm_s, z_s, cache_mem_k[i], cache_mem_v[i], w_out[i])
    y_prompt = rms_norm(xp, final_norm)
    y_sample = rms_norm(xs, final_norm)
    return (y_prompt, y_sample,
            jnp.stack(p_k), jnp.stack(p_v), jnp.stack(p_lf), jnp.stack(p_S), jnp.stack(p_conv),
            jnp.stack(p_mk), jnp.stack(p_mv),
            jnp.stack(s_k), jnp.stack(s_v), jnp.stack(s_lf), jnp.stack(s_S), jnp.stack(s_conv))
```

```cpp
#define N_LAUNCHES 1
#define ACT_T bf16_t
#define BR_T bf16_t
#define USE_MFMA_GEMM 1
#define USE_MFMA_ATTN 1
#define USE_GDN_CHUNK 1
#define OP_SPLIT 1
#include <hip/hip_runtime.h>
#include <cstdio>
#include <cstdint>

#define GAS __attribute__((address_space(1)))
#define LAS __attribute__((address_space(3)))
typedef unsigned short bf16_t;
typedef float f32x4 __attribute__((ext_vector_type(4)));
typedef float f32x2 __attribute__((ext_vector_type(2)));
typedef float f32x16 __attribute__((ext_vector_type(16)));
typedef short bf16x8 __attribute__((ext_vector_type(8)));
typedef short s16x4 __attribute__((ext_vector_type(4)));
typedef unsigned u32x4 __attribute__((ext_vector_type(4)));
typedef unsigned u32x2 __attribute__((ext_vector_type(2)));

constexpr int DM = 2048, NB = 2, SEQ = 8192, DEPTH = 4, DB = 32, DS = 16, PAST = 1024;
constexpr int HD = 128, NH = 12, MIXW = NH * HD  , NMH = 4, MEMW = NMH * HD  , BRW = 2048, NMEM = 256;
constexpr int CONVW = 4, CONVCH = 3 * MIXW  ;
constexpr int FOX_IN = 3 * MIXW + NH + MEMW + BRW  , GDN_IN = 3 * MIXW + 2 * NH + MEMW + BRW  ;
constexpr int MP = NB * SEQ  , MS = DB * DS  , MR = MP + MS  ;
constexpr int NIN = 7424;
constexpr int C_QM = 4608, C_Z = 5120, C_G = 7168;
constexpr float EPS = 1e-6f;
constexpr float ATT_SCALE = 0.08838834764831845f;
constexpr int FS_LEN = 1088;

constexpr size_t O_YP = 0;
constexpr size_t O_YS = O_YP + (size_t)MP * DM;
constexpr size_t O_PFK = O_YS + (size_t)MS * DM;
constexpr size_t O_PFV = O_PFK + (size_t)2 * MP * MIXW;
constexpr size_t O_PFL = O_PFV + (size_t)2 * MP * MIXW;
constexpr size_t O_PGS = O_PFL + (size_t)2 * MP * NH;
constexpr size_t O_PGC = O_PGS + (size_t)2 * NB * NH * HD * HD;
constexpr size_t O_PMK = O_PGC + (size_t)2 * NB * 3 * CONVCH;
constexpr size_t O_PMV = O_PMK + (size_t)DEPTH * NB * NMEM * MEMW;
constexpr size_t O_SFK = O_PMV + (size_t)DEPTH * NB * NMEM * MEMW;
constexpr size_t O_SFV = O_SFK + (size_t)2 * MS * MIXW;
constexpr size_t O_SFL = O_SFV + (size_t)2 * MS * MIXW;
constexpr size_t O_SGS = O_SFL + (size_t)2 * MS * NH;
constexpr size_t O_SGC = O_SGS + (size_t)2 * DB * NH * HD * HD;
constexpr size_t O_END = O_SGC + (size_t)2 * DB * 3 * CONVCH;
static_assert(O_END == 155224064ull, "output size");

constexpr size_t MiB = 1ull << 20;
constexpr size_t WS_CTL = 0, CTL_ZERO_BYTES = 1 * MiB;
constexpr size_t WS_WTIN = 2 * MiB;
constexpr size_t WTIN_L = (size_t)NIN * DM * 2;
constexpr size_t WS_WTOUT = WS_WTIN + 4 * WTIN_L;
constexpr size_t WTOUT_L = (size_t)DM * BRW * 2;
constexpr size_t WS_WTMKV = WS_WTOUT + 4 * WTOUT_L;
constexpr size_t WTMKV_L = (size_t)1024 * DM * 2;
constexpr size_t WS_HM = WS_WTMKV + 4 * WTMKV_L;
constexpr size_t HM_L = (size_t)512 * DM * 2;
constexpr size_t WS_H = WS_HM + 4 * HM_L;
constexpr size_t WS_QKV = WS_H + (size_t)MR * DM * 2;
constexpr size_t WS_QM = WS_QKV + (size_t)MR * CONVCH * 2;
constexpr size_t WS_ZS = WS_QM + (size_t)MR * MEMW * 2;
constexpr size_t WS_BR = WS_ZS + (size_t)MR * BRW * 2;
constexpr size_t WS_GA = WS_BR + (size_t)MR * BRW * 2;
constexpr size_t WS_BETA = WS_GA + (size_t)MR * NH * 4;
constexpr size_t WS_FP = WS_BETA + (size_t)MR * NH * 4;
constexpr size_t WS_FS = WS_FP + (size_t)NB * NH * SEQ * 4;
constexpr size_t WS_PART = ((WS_FS + (size_t)DB * NH * FS_LEN * 4 + MiB - 1) / MiB) * MiB;
#ifndef OP_KS_
#define OP_KS_ 8
#endif
constexpr int OP_KS = OP_KS_;
constexpr size_t WS_GDN = WS_PART + 64 * MiB; constexpr size_t WS_GDN_OLD_ = ((WS_FS + (size_t)DB * NH * FS_LEN * 4 + MiB - 1) / MiB) * MiB;
constexpr size_t WS_END_MIN = WS_GDN + 640 * MiB;

constexpr size_t WS_ZERO = 512 * 1024;
constexpr int CW_KN = 12288;
constexpr size_t WS_QN = 768 * 1024;
constexpr int CW_TMO = 0, CW_CODE = 1, CW_BAR = 4096, CW_Q = 16384;

__device__ __forceinline__ float bf2f(bf16_t v) { return __uint_as_float((unsigned)v << 16); }
__device__ __forceinline__ bf16_t f2bf(float f) { unsigned u = __float_as_uint(f); return (bf16_t)((u + 0x7fffu + ((u >> 16) & 1u)) >> 16); }
__device__ __forceinline__ unsigned pk2(float lo, float hi) { return (unsigned)f2bf(lo) | ((unsigned)f2bf(hi) << 16); }
__device__ __forceinline__ float ldf(const float* p) { return *p; }
__device__ __forceinline__ float ldf(const bf16_t* p) { return bf2f(*p); }
__device__ __forceinline__ void stf(float* p, float v) { *p = v; }
__device__ __forceinline__ void stf(bf16_t* p, float v) { *p = f2bf(v); }
__device__ __forceinline__ float shfl_xor_l(float v, int off, int lane) { return __int_as_float(__builtin_amdgcn_ds_bpermute((lane ^ off) << 2, __float_as_int(v))); }
__device__ __forceinline__ float wave_sum(float v, int lane) {
#pragma unroll
    for (int o = 1; o < 64; o <<= 1) v += shfl_xor_l(v, o, lane);
    return v;
}
__device__ __forceinline__ float siluf(float x) { return x / (1.f + __expf(-x)); }
__device__ __forceinline__ float softplusf(float x) { return fmaxf(x, 0.f) + log1pf(__expf(-fabsf(x))); }
__device__ __forceinline__ float logsigmoidf(float x) { return -softplusf(-x); }
__device__ __forceinline__ float sigmoidf_(float x) { return 1.f / (1.f + __expf(-x)); }

#define XB_TMO      128
#define XB_XCNT(j)  (256  + 64 * (j))
#define XB_XSUB(j)  (1280 + 64 * (j))
#define XB_XGEN(j)  (2304 + 64 * (j))
#define XB_TOP      3328
#define XB_TOPGEN   3392
#define XCD_BAR_WORDS 3456
#define XB_SPIN_CAP (1u << 19)
__device__ __forceinline__ unsigned xb_ld(unsigned* p)              { return __hip_atomic_load(p, __ATOMIC_RELAXED, __HIP_MEMORY_SCOPE_AGENT); }
__device__ __forceinline__ unsigned xb_add(unsigned* p, unsigned v) { return __hip_atomic_fetch_add(p, v, __ATOMIC_RELAXED, __HIP_MEMORY_SCOPE_AGENT); }
__device__ __forceinline__ unsigned xb_xcc_id() { return (unsigned)__builtin_amdgcn_s_getreg((3 << 11) | 20) & 0xFu; }
#define XB_SPIN(cond, bar) do { unsigned _sp = 0; while (cond) { __builtin_amdgcn_s_sleep(1); \
    if ((++_sp & 255u) == 0u) { if (xb_ld(&(bar)[XB_TMO])) break; if (_sp > XB_SPIN_CAP) { atomicAdd(&(bar)[XB_TMO], 1u); break; } } } } while (0)
struct XcdBarrier { unsigned* bar; unsigned x; volatile LAS unsigned* st; };
__device__ __forceinline__ XcdBarrier xcd_barrier_post(unsigned* bar, volatile LAS unsigned* st, int tid) {
    XcdBarrier b; b.bar = bar; b.x = xb_xcc_id(); b.st = st;
    if (tid == 0) (void)xb_add(&bar[XB_XCNT(b.x)], 1u);
    return b;
}
__device__ __forceinline__ void xcd_barrier_complete(unsigned* bar, unsigned x, unsigned& nloc, unsigned& nx) {
    const unsigned G = gridDim.x * gridDim.y * gridDim.z;
    unsigned sum, cnt, mine, sp = 0u;
    for (;;) {
        sum = 0u; cnt = 0u; mine = 0u;
#pragma unroll
        for (unsigned j = 0; j < 16; ++j) { const unsigned c = xb_ld(&bar[XB_XCNT(j)]); sum += c; cnt += (c > 0u) ? 1u : 0u; mine = (j == x) ? c : mine; }
        if (sum == G) break;
        __builtin_amdgcn_s_sleep(1);
        if ((++sp & 255u) == 0u) { if (xb_ld(&bar[XB_TMO])) break; if (sp > XB_SPIN_CAP) { atomicAdd(&bar[XB_TMO], 1u); break; } }
    }
    nloc = mine > 0u ? mine : 1u; nx = cnt > 0u ? cnt : 1u;
}
__device__ __forceinline__ void xcd_barrier(const XcdBarrier& b, int tid) {
    asm volatile("s_waitcnt vmcnt(0)" ::: "memory");
    __syncthreads();
    if (tid == 0) {
        unsigned* bar = b.bar;
        __builtin_amdgcn_s_waitcnt(0);
        unsigned nloc = b.st[0], nx = b.st[1];
        if (nloc == 0u) { xcd_barrier_complete(bar, b.x, nloc, nx); b.st[0] = nloc; b.st[1] = nx; }
        const unsigned old = xb_add(&bar[XB_XSUB(b.x)], 1u);
        const unsigned gen = old / nloc;
        if (old + 1u == (gen + 1u) * nloc) {
            __builtin_amdgcn_fence(__ATOMIC_RELEASE, "agent");
            asm volatile("s_waitcnt vmcnt(0)" ::: "memory");
            const unsigned og = xb_add(&bar[XB_TOP], 1u);
            const unsigned tg = og / nx;
            if (og + 1u == (tg + 1u) * nx) xb_add(&bar[XB_TOPGEN], 1u);
            else XB_SPIN(xb_ld(&bar[XB_TOPGEN]) == tg, bar);
            __builtin_amdgcn_fence(__ATOMIC_ACQUIRE, "agent");
            xb_add(&bar[XB_XGEN(b.x)], 1u);
            asm volatile("s_waitcnt vmcnt(0)" ::: "memory");
        } else {
            XB_SPIN(xb_ld(&bar[XB_XGEN(b.x)]) == gen, bar);
            __builtin_amdgcn_fence(__ATOMIC_ACQUIRE, "agent");
            asm volatile("s_waitcnt vmcnt(0)" ::: "memory");
        }
    }
    __syncthreads();
}
#ifndef OP_SPLIT
#define OP_SPLIT 0
#endif
typedef ACT_T act_t;
typedef BR_T br_t;
constexpr int NT = 512;
constexpr int NWAVES = 8;

constexpr int PTR_OFF = 131072 + 512;
struct Frame {
    LAS unsigned char* lds;
    int tid, lane, wave, G, bid;
    __device__ __forceinline__ unsigned long long ptr(int i) const {
        const volatile LAS unsigned* t = (const volatile LAS unsigned*)(lds + PTR_OFF) + 2 * i;
        const unsigned lo = __builtin_amdgcn_readfirstlane(t[0]), hi = __builtin_amdgcn_readfirstlane(t[1]);
        return ((unsigned long long)hi << 32) | lo;
    }
    __device__ __forceinline__ const float* in(int i) const { return (const float*)(const GAS float*)ptr(i); }
    __device__ __forceinline__ float* out() const { return (float*)(GAS float*)ptr(22); }
    __device__ __forceinline__ unsigned char* ws() const { return (unsigned char*)(GAS unsigned char*)ptr(23); }
    __device__ __forceinline__ unsigned* ctl() const { return (unsigned*)(ws() + WS_CTL); }
    __device__ __forceinline__ bf16_t* wt_in(int L) const { return (bf16_t*)(ws() + WS_WTIN + (size_t)L * WTIN_L); }
    __device__ __forceinline__ bf16_t* wt_out(int L) const { return (bf16_t*)(ws() + WS_WTOUT + (size_t)L * WTOUT_L); }
    __device__ __forceinline__ bf16_t* wt_mkv(int L) const { return (bf16_t*)(ws() + WS_WTMKV + (size_t)L * WTMKV_L); }
    __device__ __forceinline__ bf16_t* hm(int L) const { return (bf16_t*)(ws() + WS_HM + (size_t)L * HM_L); }
    __device__ __forceinline__ bf16_t* h() const { return (bf16_t*)(ws() + WS_H); }
    __device__ __forceinline__ act_t* qkv() const { return (act_t*)(ws() + WS_QKV); }
    __device__ __forceinline__ act_t* qm() const { return (act_t*)(ws() + WS_QM); }
    __device__ __forceinline__ act_t* zs() const { return (act_t*)(ws() + WS_ZS); }
    __device__ __forceinline__ br_t* br() const { return (br_t*)(ws() + WS_BR); }
    __device__ __forceinline__ float* ga() const { return (float*)(ws() + WS_GA); }
    __device__ __forceinline__ float* beta() const { return (float*)(ws() + WS_BETA); }
    __device__ __forceinline__ float* fp() const { return (float*)(ws() + WS_FP); }
    __device__ __forceinline__ float* fs() const { return (float*)(ws() + WS_FS); }
};

__host__ __device__ __forceinline__ int inproj_src_col(int L, int n) {
    const int ng = (L & 1) ? 2 * NH : NH;
    if (n < CONVCH) return n;
    if (n < C_G) return n + ng;
    if (n < C_G + ng) return n - C_G + CONVCH;
    return -1;
}

__device__ __forceinline__ void transpose_tile(Frame& F, const float* W, int ldw, int k0, int n0, bf16_t* WT, int K, int L, int kind  ) {
    LAS float* t = (LAS float*)F.lds;
#pragma unroll
    for (int i = 0; i < 8; ++i) {
        const int idx = F.tid + NT * i, kk = idx >> 6, nn = idx & 63;
        const int sc = kind == 0 ? inproj_src_col(L, n0 + nn) : (n0 + nn);
        t[kk * 65 + nn] = sc >= 0 ? W[(size_t)(k0 + kk) * ldw + sc] : 0.f;
    }
    __syncthreads();
#pragma unroll
    for (int i = 0; i < 4; ++i) {
        const int idx = F.tid + NT * i, nn = idx >> 5, kp = idx & 31;
        const unsigned w = pk2(t[(2 * kp) * 65 + nn], t[(2 * kp + 1) * 65 + nn]);
        *(unsigned*)(WT + (size_t)(n0 + nn) * K + k0 + 2 * kp) = w;
    }
    __syncthreads();
}
__device__ __forceinline__ void rms_row_to_bf16(Frame& F, const float* xrow, const float* gain, bf16_t* orow) {
    const f32x4* xr = (const f32x4*)xrow + F.lane;
    const f32x4* gr = (const f32x4*)gain + F.lane;
    f32x4 v[8]; float s = 0.f;
#pragma unroll
    for (int j = 0; j < 8; ++j) { v[j] = xr[64 * j]; s += (v[j].x * v[j].x + v[j].y * v[j].y) + (v[j].z * v[j].z + v[j].w * v[j].w); }
    const float rstd = 1.f / sqrtf(wave_sum(s, F.lane) * (1.f / DM) + EPS);
    unsigned long long* o8 = (unsigned long long*)orow + F.lane;
#pragma unroll
    for (int j = 0; j < 8; ++j) { const f32x4 g = gr[64 * j];
        o8[64 * j] = (unsigned long long)pk2(v[j].x * rstd * g.x, v[j].y * rstd * g.y) | ((unsigned long long)pk2(v[j].z * rstd * g.z, v[j].w * rstd * g.w) << 32); }
}
__device__ __forceinline__ void convert_weights(Frame& F, int Lb, int Le, int wi, int nw) {
    constexpr int T_IN = 32 * (NIN / 64), T_OUT = 32 * (DM / 64), T_MKV = 32 * (1024 / 64), T_L = T_IN + T_OUT + T_MKV;
    for (int it = wi; it < (Le - Lb) * T_L; it += nw) {
        const int L = Lb + it / T_L; int r = it % T_L;
        if (r < T_IN) { const int kb = r / (NIN / 64), nb = r % (NIN / 64);
            const float* W = (L & 1) ? F.in(15) + (size_t)(L >> 1) * DM * GDN_IN : F.in(13) + (size_t)(L >> 1) * DM * FOX_IN;
            transpose_tile(F, W, (L & 1) ? GDN_IN : FOX_IN, kb * 64, nb * 64, F.wt_in(L), DM, L, 0); continue; }
        r -= T_IN;
        if (r < T_OUT) { const int kb = r / (DM / 64), nb = r % (DM / 64);
            transpose_tile(F, F.in(20) + (size_t)L * BRW * DM, DM, kb * 64, nb * 64, F.wt_out(L), BRW, L, 1); continue; }
        r -= T_OUT;
        { const int kb = r / 16, nb = r % 16;
            transpose_tile(F, F.in(12) + (size_t)L * DM * 1024, 1024, kb * 64, nb * 64, F.wt_mkv(L), DM, L, 1); }
    }
}
__device__ __forceinline__ void p_prologue(Frame& F) {
    convert_weights(F, 0, 2, F.bid, F.G);
    { constexpr int T_MKV = 32 * 16; for (int it = F.bid; it < 2 * T_MKV; it += F.G) { const int L = 2 + it / T_MKV, r = it % T_MKV;
        transpose_tile(F, F.in(12) + (size_t)L * DM * 1024, 1024, (r / 16) * 64, (r % 16) * 64, F.wt_mkv(L), DM, L, 1); } }
    const int gw = F.bid * NWAVES + F.wave, NGW = F.G * NWAVES;
    for (int m = gw; m < 4 * 512; m += NGW) { const int L = m >> 9, row = m & 511;
        rms_row_to_bf16(F, F.in(2) + (size_t)row * DM, F.in(11) + (size_t)L * DM, F.hm(L) + (size_t)row * DM); }
}
__device__ __forceinline__ void load_resid_row(Frame& F, int L, int r, f32x4 (&v)[8]) {
    if (L == 0) { const f32x4* xr = (const f32x4*)(r < MP ? F.in(0) + (size_t)r * DM : F.in(1) + (size_t)(r - MP) * DM) + F.lane;
#pragma unroll
        for (int j = 0; j < 8; ++j) v[j] = xr[64 * j];
        if (r >= MP) { f32x4* xo = (f32x4*)(F.out() + (size_t)r * DM) + F.lane;
#pragma unroll
            for (int j = 0; j < 8; ++j) xo[64 * j] = v[j]; }
        return; }
    f32x4* xr = (f32x4*)(F.out() + (size_t)r * DM) + F.lane;
#pragma unroll
    for (int j = 0; j < 8; ++j) v[j] = xr[64 * j];
    if (OP_SPLIT && r >= MP) { const f32x4* pp = (const f32x4*)(F.ws() + WS_PART) + (size_t)(r - MP) * (DM / 4) + F.lane;
#pragma unroll 1
        for (int s = 0; s < OP_KS; ++s) {
#pragma unroll
            for (int j = 0; j < 8; ++j) v[j] += pp[(size_t)s * MS * (DM / 4) + 64 * j]; }
#pragma unroll
        for (int j = 0; j < 8; ++j) xr[64 * j] = v[j]; }
}
__device__ __forceinline__ void p_norm(Frame& F, int L) {
    const int gw = F.bid * NWAVES + F.wave, NGW = F.G * NWAVES;
    for (int r = gw; r < MR; r += NGW) {
        f32x4 v[8]; load_resid_row(F, L, r, v);
        const f32x4* gr = (const f32x4*)(F.in(10) + (size_t)L * DM) + F.lane; float s = 0.f;
#pragma unroll
        for (int j = 0; j < 8; ++j) s += (v[j].x * v[j].x + v[j].y * v[j].y) + (v[j].z * v[j].z + v[j].w * v[j].w);
        const float rstd = 1.f / sqrtf(wave_sum(s, F.lane) * (1.f / DM) + EPS);
        unsigned long long* o8 = (unsigned long long*)(F.h() + (size_t)r * DM) + F.lane;
#pragma unroll
        for (int j = 0; j < 8; ++j) { const f32x4 g = gr[64 * j];
            o8[64 * j] = (unsigned long long)pk2(v[j].x * rstd * g.x, v[j].y * rstd * g.y) | ((unsigned long long)pk2(v[j].z * rstd * g.z, v[j].w * rstd * g.w) << 32); }
    }
}
__device__ __forceinline__ void p_final_norm(Frame& F) {
    const int gw = F.bid * NWAVES + F.wave, NGW = F.G * NWAVES;
    for (int r = gw; r < MR; r += NGW) {
        f32x4 v[8]; load_resid_row(F, 4, r, v);
        f32x4* xr = (f32x4*)(F.out() + (size_t)r * DM) + F.lane;
        const f32x4* gr = (const f32x4*)F.in(21) + F.lane; float s = 0.f;
#pragma unroll
        for (int j = 0; j < 8; ++j) s += (v[j].x * v[j].x + v[j].y * v[j].y) + (v[j].z * v[j].z + v[j].w * v[j].w);
        const float rstd = 1.f / sqrtf(wave_sum(s, F.lane) * (1.f / DM) + EPS);
#pragma unroll
        for (int j = 0; j < 8; ++j) { const f32x4 g = gr[64 * j]; xr[64 * j] = v[j] * rstd * g; }
    }
}

struct EpiInProj {
    int L; float* out; act_t* qkv; act_t* qm; act_t* zs; float* ga; float* beta; const float* bfor; const float* alog; const float* dtb;
    __device__ __forceinline__ void operator()(int r, int c, float v) const {
        const int j = L >> 1;
        if (c < CONVCH) {
            stf(qkv + (size_t)r * CONVCH + c, v);
            if (!(L & 1)) {
                if (c >= MIXW) { const int isv = c >= 2 * MIXW, cc = c - (isv ? 2 * MIXW : MIXW);
                    float* o = r < MP ? out + (isv ? O_PFV : O_PFK) + ((size_t)j * MP + r) * MIXW + cc
                                      : out + (isv ? O_SFV : O_SFK) + ((size_t)j * MS + (r - MP)) * MIXW + cc;
                    *o = v; }
            } else {
                if (r < MP) { const int t = r & (SEQ - 1), b = r >> 13; if (t >= SEQ - 3) out[O_PGC + (((size_t)j * NB + b) * 3 + (t - (SEQ - 3))) * CONVCH + c] = v; }
                else { const int s = r - MP, l = s & 15, bs = s >> 4; if (l >= DS - 3) out[O_SGC + (((size_t)j * DB + bs) * 3 + (l - (DS - 3))) * CONVCH + c] = v; }
            }
        } else if (c < C_Z) { stf(qm + (size_t)r * MEMW + (c - C_QM), v);
        } else if (c < C_G) { stf(zs + (size_t)r * BRW + (c - C_Z), siluf(v));
        } else if (!(L & 1)) {
            if (c < C_G + NH) { const int hh = c - C_G; const float lf = logsigmoidf(v + bfor[j * NH + hh]);
                if (r < MP) out[O_PFL + ((size_t)j * MP + r) * NH + hh] = lf; else out[O_SFL + ((size_t)j * MS + (r - MP)) * NH + hh] = lf; }
        } else {
            if (c < C_G + NH) { const int hh = c - C_G;
                ga[(size_t)r * NH + hh] = -__expf(alog[j * NH + hh]) * softplusf(v + dtb[j * NH + hh]); }
            else if (c < C_G + 2 * NH) { const int hh = c - C_G - NH; beta[(size_t)r * NH + hh] = sigmoidf_(v); }
        }
    }
};
__device__ __forceinline__ EpiInProj mk_epi_inproj(const Frame& F, int L) {
    EpiInProj e; e.L = L; e.out = F.out(); e.qkv = F.qkv(); e.qm = F.qm(); e.zs = F.zs(); e.ga = F.ga(); e.beta = F.beta(); e.bfor = F.in(14); e.alog = F.in(17); e.dtb = F.in(18); return e;
}
struct EpiOutProj {
    int L; float* out; const float* xp; const float* xs;
    __device__ __forceinline__ void operator()(int r, int c, float v) const {
        const float xo = L == 0 ? (r < MP ? xp[(size_t)r * DM + c] : xs[(size_t)(r - MP) * DM + c]) : out[(size_t)r * DM + c];
        out[(size_t)r * DM + c] = xo + v;
    }
};
struct EpiMemKV {
    int L; float* out;
    __device__ __forceinline__ void operator()(int r, int c, float v) const {
        if (c < MEMW) out[O_PMK + ((size_t)L * 512 + r) * MEMW + c] = v; else out[O_PMV + ((size_t)L * 512 + r) * MEMW + (c - MEMW)] = v;
    }
};

template <class TA, class Epi>
__device__ __forceinline__ void gemm_naive_tile(Frame& F, const TA* A, const bf16_t* Bt, int K, int pm, int pn, const Epi& epi) {
    LAS float* As = (LAS float*)F.lds;
    LAS float* Bs = As + 32 * 132;
    const int ty = F.tid >> 5, tx = F.tid & 31;
    float acc[8][4];
#pragma unroll
    for (int i = 0; i < 8; ++i)
#pragma unroll
        for (int j = 0; j < 4; ++j) acc[i][j] = 0.f;
    for (int k0 = 0; k0 < K; k0 += 32) {
#pragma unroll
        for (int i = 0; i < 8; ++i) { const int idx = F.tid + NT * i, row = idx >> 5, kk = idx & 31;
            As[kk * 132 + row] = ldf(A + (size_t)(pm * 128 + row) * K + k0 + kk);
            Bs[kk * 132 + row] = bf2f(Bt[(size_t)(pn * 128 + row) * K + k0 + kk]); }
        __syncthreads();
#pragma unroll 8
        for (int kk = 0; kk < 32; ++kk) {
            const f32x4 a0 = *(const LAS f32x4*)(As + kk * 132 + ty * 8), a1 = *(const LAS f32x4*)(As + kk * 132 + ty * 8 + 4);
            const f32x4 b = *(const LAS f32x4*)(Bs + kk * 132 + tx * 4);
            const float a[8] = {a0.x, a0.y, a0.z, a0.w, a1.x, a1.y, a1.z, a1.w};
#pragma unroll
            for (int i = 0; i < 8; ++i) { acc[i][0] += a[i] * b.x; acc[i][1] += a[i] * b.y; acc[i][2] += a[i] * b.z; acc[i][3] += a[i] * b.w; }
        }
        __syncthreads();
    }
#pragma unroll
    for (int i = 0; i < 8; ++i)
#pragma unroll
        for (int j = 0; j < 4; ++j) epi(pm * 128 + ty * 8 + i, pn * 128 + tx * 4 + j, acc[i][j]);
}
template <class TA, class Epi>
__device__ __forceinline__ void gemm_naive(Frame& F, const TA* A, const bf16_t* Bt, int M, int N, int K, const Epi& epi) {
    const int ntn = N / 128, nt = (M / 128) * ntn;
    for (int t = F.bid; t < nt; t += F.G) gemm_naive_tile(F, A, Bt, K, t / ntn, t % ntn, epi);
}

__device__ __forceinline__ float block_excl_prefix(Frame& F, float s) {
    LAS float* wsum = (LAS float*)F.lds;
    float incl = s;
#pragma unroll
    for (int o = 1; o < 64; o <<= 1) { const float up = __int_as_float(__builtin_amdgcn_ds_bpermute(((F.lane - o) & 63) << 2, __float_as_int(incl))); if (F.lane >= o) incl += up; }
    __syncthreads();
    if (F.lane == 63) wsum[F.wave] = incl;
    __syncthreads();
    float base = 0.f;
#pragma unroll
    for (int w = 0; w < 8; ++w) if (w < F.wave) base += wsum[w];
    return base + incl - s;
}
__device__ __forceinline__ void cumsum_unit(Frame& F, int j, int u) {
    if (u < NB * NH) {
        const int b = u / NH, hh = u % NH;
        const float* src = F.out() + O_PFL + ((size_t)j * MP + (size_t)b * SEQ) * NH + hh;
        float v[16]; float s = 0.f;
#pragma unroll
        for (int i = 0; i < 16; ++i) { v[i] = src[(size_t)(F.tid * 16 + i) * NH]; s += v[i]; }
        float run = block_excl_prefix(F, s); float* dst = F.fp() + ((size_t)b * NH + hh) * SEQ + F.tid * 16;
#pragma unroll
        for (int i = 0; i < 16; ++i) { run += v[i]; dst[i] = run; }
    } else {
        const int s_ = u - NB * NH, bs = s_ / NH, hh = s_ % NH;
        const float* c = F.in(5) + (((size_t)j * DB + bs) * PAST) * NH + hh;
        const float* nw = F.out() + O_SFL + ((size_t)j * MS + (size_t)bs * DS) * NH + hh;
        float v[4] = {0.f, 0.f, 0.f, 0.f}; float s = 0.f;
        if (F.tid < 260) {
#pragma unroll
            for (int i = 0; i < 4; ++i) { const int p = F.tid * 4 + i; v[i] = p < PAST ? c[(size_t)p * NH] : nw[(size_t)(p - PAST) * NH]; s += v[i]; } }
        float run = block_excl_prefix(F, s);
        float* dst = F.fs() + ((size_t)bs * NH + hh) * FS_LEN;
        if (F.tid < 260) {
#pragma unroll
            for (int i = 0; i < 4; ++i) { run += v[i]; dst[F.tid * 4 + i] = run; } }
        else if (F.tid < 272) {
#pragma unroll
            for (int i = 0; i < 4; ++i) dst[F.tid * 4 + i] = run; }
    }
}
__device__ __forceinline__ void qknorm_unit(Frame& F, int L, int u) {
    const int qb = u & 31, bh = u >> 5, b = bh / NH, hh = bh % NH;
    LAS float* red = (LAS float*)F.lds;
    const bf16_t* base = (const bf16_t*)F.qkv() + ((size_t)b * SEQ + (size_t)qb * 256 + (F.tid >> 1)) * CONVCH + hh * HD + (F.tid & 1) * 64;
    float sq = 0.f, sk = 0.f;
#pragma unroll
    for (int c = 0; c < 8; ++c) { const bf16x8 qv = *(const bf16x8*)(base + 8 * c), kv = *(const bf16x8*)(base + MIXW + 8 * c);
#pragma unroll
        for (int e = 0; e < 8; ++e) { const float a = __uint_as_float((unsigned)(unsigned short)qv[e] << 16), k = __uint_as_float((unsigned)(unsigned short)kv[e] << 16); sq += a * a; sk += k * k; } }
    sq += shfl_xor_l(sq, 1, F.lane); sk += shfl_xor_l(sk, 1, F.lane);
#pragma unroll
    for (int o = 2; o < 64; o <<= 1) { sq = fmaxf(sq, shfl_xor_l(sq, o, F.lane)); sk = fmaxf(sk, shfl_xor_l(sk, o, F.lane)); }
    __syncthreads();
    if (F.lane == 0) { red[F.wave] = sq; red[8 + F.wave] = sk; }
    __syncthreads();
    if (F.tid == 0) { float mq = red[0], mk = red[8];
#pragma unroll
        for (int w = 1; w < 8; ++w) { mq = fmaxf(mq, red[w]); mk = fmaxf(mk, red[8 + w]); }
        ((float*)(F.ws() + WS_QN))[bh * 32 + qb] = mq;
        atomicMax(F.ctl() + CW_KN + L * 32 + bh, __float_as_uint(mk)); }
}
__device__ __forceinline__ void p_cumsum(Frame& F, int L) {
    const int j = L >> 1; const int n1 = NB * NH + DB * NH;
    for (int u = F.bid; u < n1 + NB * NH * 32; u += F.G) { if (u < n1) cumsum_unit(F, j, u); else qknorm_unit(F, L, u - n1); }
}

struct NAttn {
    const act_t* Q; int q_stride;
    const float* K1; const float* V1; int s1, n1;
    const float* K2; const float* V2; int s2;
    int nkeys; const float* Fk;
    int pos0;
    int nrows;
    br_t* O; const act_t* Z; int o_stride;
};
__device__ __forceinline__ void nattn_unit(Frame& F, const NAttn& a) {
    LAS float* Qs = (LAS float*)F.lds;
    LAS float* Ks = Qs + 16 * 128;
    LAS float* Vs = Ks + 64 * 129;
    LAS float* Ps = Vs + 64 * 128;
    const int qi = F.tid >> 5, kl = F.tid & 31;
    __syncthreads();
#pragma unroll
    for (int i = 0; i < 4; ++i) { const int idx = F.tid + NT * i, r = idx >> 7, d = idx & 127;
        Qs[idx] = r < a.nrows ? ldf(a.Q + (size_t)r * a.q_stride + d) : 0.f; }
    float o[4] = {0.f, 0.f, 0.f, 0.f}; float m_run = -1e30f, l_run = 0.f;
    const int pos = a.pos0 + qi;
    const float fq = (a.Fk && qi < a.nrows) ? a.Fk[pos < a.nkeys ? pos : a.nkeys - 1] : 0.f;
    int jmax = a.pos0 + a.nrows; if (jmax > a.nkeys) jmax = a.nkeys;
    for (int j0 = 0; j0 < jmax; j0 += 64) {
        __syncthreads();
#pragma unroll 2
        for (int i = 0; i < 16; ++i) { const int kr = (F.tid >> 7) + 4 * i, d = F.tid & 127, j = j0 + kr;
            float kv = 0.f, vv = 0.f;
            if (j < a.nkeys) { const bool first = j < a.n1; const float* kp = first ? a.K1 : a.K2; const float* vp = first ? a.V1 : a.V2;
                const size_t off = first ? (size_t)j * a.s1 + d : (size_t)(j - a.n1) * a.s2 + d; kv = kp[off]; vv = vp[off]; }
            Ks[kr * 129 + d] = kv; Vs[kr * 128 + d] = vv; }
        __syncthreads();
        float s[2];
#pragma unroll
        for (int e = 0; e < 2; ++e) { const int kk = kl + 32 * e, j = j0 + kk; float acc = 0.f;
            for (int d = 0; d < 128; ++d) acc += Qs[qi * 128 + d] * Ks[kk * 129 + d];
            const bool ok = j < a.nkeys && j <= pos && qi < a.nrows;
            float bias = 0.f; if (a.Fk && ok) bias = fq - a.Fk[j];
            s[e] = ok ? acc * ATT_SCALE + bias : -__builtin_inff(); }
        float mt = fmaxf(s[0], s[1]);
#pragma unroll
        for (int off = 16; off >= 1; off >>= 1) mt = fmaxf(mt, shfl_xor_l(mt, off, F.lane));
        const float m_new = fmaxf(m_run, mt), alpha = __expf(m_run - m_new);
        const float p0 = __expf(s[0] - m_new), p1 = __expf(s[1] - m_new);
        float ps = p0 + p1;
#pragma unroll
        for (int off = 16; off >= 1; off >>= 1) ps += shfl_xor_l(ps, off, F.lane);
        l_run = l_run * alpha + ps; m_run = m_new;
        Ps[qi * 64 + kl] = p0; Ps[qi * 64 + kl + 32] = p1;
#pragma unroll
        for (int c = 0; c < 4; ++c) o[c] *= alpha;
        __syncthreads();
        for (int kk = 0; kk < 64; ++kk) { const float p = Ps[qi * 64 + kk]; const f32x4 v = *(const LAS f32x4*)(Vs + kk * 128 + kl * 4);
            o[0] += p * v.x; o[1] += p * v.y; o[2] += p * v.z; o[3] += p * v.w; }
    }
    if (qi < a.nrows) { const float inv = 1.f / l_run;
#pragma unroll
        for (int c = 0; c < 4; ++c) { const size_t off = (size_t)qi * a.o_stride + kl * 4 + c; stf(a.O + off, o[c] * inv * ldf(a.Z + off)); } }
    __syncthreads();
}
__device__ __forceinline__ NAttn mk_fox_prompt(Frame& F, int L, int b, int hh, int row0, int nrows) {
    const int j = L >> 1; NAttn a;
    a.Q = F.qkv() + ((size_t)b * SEQ + row0) * CONVCH + hh * HD; a.q_stride = CONVCH;
    a.K1 = F.out() + O_PFK + ((size_t)j * MP + (size_t)b * SEQ) * MIXW + hh * HD; a.V1 = F.out() + O_PFV + ((size_t)j * MP + (size_t)b * SEQ) * MIXW + hh * HD;
    a.s1 = MIXW; a.n1 = SEQ; a.K2 = a.K1; a.V2 = a.V1; a.s2 = MIXW; a.nkeys = SEQ;
    a.Fk = F.fp() + ((size_t)b * NH + hh) * SEQ; a.pos0 = row0; a.nrows = nrows;
    a.O = F.br() + ((size_t)b * SEQ + row0) * BRW + hh * HD; a.Z = F.zs() + ((size_t)b * SEQ + row0) * BRW + hh * HD; a.o_stride = BRW;
    return a;
}
__device__ __forceinline__ NAttn mk_fox_sample(Frame& F, int L, int bs, int hh) {
    const int j = L >> 1; NAttn a; const size_t r0 = (size_t)MP + (size_t)bs * DS;
    a.Q = F.qkv() + r0 * CONVCH + hh * HD; a.q_stride = CONVCH;
    a.K1 = F.in(3) + (((size_t)j * DB + bs) * PAST) * MIXW + hh * HD; a.V1 = F.in(4) + (((size_t)j * DB + bs) * PAST) * MIXW + hh * HD; a.s1 = MIXW; a.n1 = PAST;
    a.K2 = F.out() + O_SFK + ((size_t)j * MS + (size_t)bs * DS) * MIXW + hh * HD; a.V2 = F.out() + O_SFV + ((size_t)j * MS + (size_t)bs * DS) * MIXW + hh * HD; a.s2 = MIXW;
    a.nkeys = PAST + DS; a.Fk = F.fs() + ((size_t)bs * NH + hh) * FS_LEN; a.pos0 = PAST; a.nrows = DS;
    a.O = F.br() + r0 * BRW + hh * HD; a.Z = F.zs() + r0 * BRW + hh * HD; a.o_stride = BRW;
    return a;
}
__device__ __forceinline__ NAttn mk_mem_prompt(Frame& F, int L, int b, int hm, int row0, int nrows) {
    NAttn a;
    a.Q = F.qm() + ((size_t)b * SEQ + row0) * MEMW + hm * HD; a.q_stride = MEMW;
    a.K1 = F.out() + O_PMK + ((size_t)L * 512 + (size_t)b * NMEM) * MEMW + hm * HD; a.V1 = F.out() + O_PMV + ((size_t)L * 512 + (size_t)b * NMEM) * MEMW + hm * HD;
    a.s1 = MEMW; a.n1 = NMEM; a.K2 = a.K1; a.V2 = a.V1; a.s2 = MEMW; a.nkeys = NMEM; a.Fk = nullptr; a.pos0 = NMEM; a.nrows = nrows;
    a.O = F.br() + ((size_t)b * SEQ + row0) * BRW + MIXW + hm * HD; a.Z = F.zs() + ((size_t)b * SEQ + row0) * BRW + MIXW + hm * HD; a.o_stride = BRW;
    return a;
}
__device__ __forceinline__ NAttn mk_mem_sample(Frame& F, int L, int bs, int hm) {
    NAttn a; const size_t r0 = (size_t)MP + (size_t)bs * DS;
    a.Q = F.qm() + r0 * MEMW + hm * HD; a.q_stride = MEMW;
    a.K1 = F.in(8) + (((size_t)L * DB + bs) * NMEM) * MEMW + hm * HD; a.V1 = F.in(9) + (((size_t)L * DB + bs) * NMEM) * MEMW + hm * HD;
    a.s1 = MEMW; a.n1 = NMEM; a.K2 = a.K1; a.V2 = a.V1; a.s2 = MEMW; a.nkeys = NMEM; a.Fk = nullptr; a.pos0 = NMEM; a.nrows = DS;
    a.O = F.br() + r0 * BRW + MIXW + hm * HD; a.Z = F.zs() + r0 * BRW + MIXW + hm * HD; a.o_stride = BRW;
    return a;
}

struct NGdn {
    int j, hh; size_t row0; int nT;
    const float* hist;
    const float* S0;
    float* Sout;
};
__device__ __forceinline__ void ngdn_unit(Frame& F, const NGdn& u) {
    LAS float* raw = (LAS float*)F.lds;
    LAS float* qs = raw + 384;
    LAS float* ks = qs + 128;
    LAS float* vs = ks + 128;
    LAS float* red = vs + 128;
    LAS float* red2 = red + 512;
    LAS float* wsum = red2 + 512;
    const int dvc = F.tid & 127, dkg = F.tid >> 7;
    const float* cw = F.in(16) + (size_t)u.j * CONVW * CONVCH;
    const float* gain = F.in(19) + (size_t)u.j * HD;
    float S[32];
#pragma unroll
    for (int i = 0; i < 32; ++i) S[i] = u.S0 ? u.S0[(size_t)(dkg * 32 + i) * HD + dvc] : 0.f;
    const int sel = F.tid >> 7;
    const int col = sel * MIXW + u.hh * HD + (F.tid & 127);
    float w4[4] = {0.f, 0.f, 0.f, 0.f};
    if (F.tid < 384) {
#pragma unroll
        for (int jj = 0; jj < 4; ++jj) w4[jj] = cw[(size_t)jj * CONVCH + col]; }
    __syncthreads();
    for (int t = 0; t < u.nT; ++t) {
        const size_t row = u.row0 + t;
        float val = 0.f;
        if (F.tid < 384) { float y = 0.f;
#pragma unroll
            for (int jj = 0; jj < 4; ++jj) { const int tau = t - 3 + jj; float x;
                if (tau >= 0) x = ldf(F.qkv() + (u.row0 + tau) * CONVCH + col); else x = u.hist ? u.hist[(size_t)(3 + tau) * CONVCH + col] : 0.f;
                y += w4[jj] * x; }
            val = siluf(y); raw[F.tid] = val; }
        const float sq = wave_sum(val * val, F.lane);
        if (F.lane == 0) wsum[F.wave] = sq;
        __syncthreads();
        const float nq = wsum[0] + wsum[1], nk = wsum[2] + wsum[3];
        if (F.tid < 128) qs[F.tid] = raw[F.tid] * (1.f / sqrtf(nq + EPS)) * ATT_SCALE;
        else if (F.tid < 256) ks[F.tid - 128] = raw[F.tid] * (1.f / sqrtf(nk + EPS));
        else if (F.tid < 384) vs[F.tid - 256] = raw[F.tid];
        __syncthreads();
        const float g = F.ga()[row * NH + u.hh], beta = F.beta()[row * NH + u.hh], eg = __expf(g);
        float part = 0.f;
#pragma unroll
        for (int i = 0; i < 32; ++i) part += ks[dkg * 32 + i] * S[i];
        red[dkg * 128 + dvc] = part;
        __syncthreads();
        const float kS = (red[dvc] + red[128 + dvc] + red[256 + dvc] + red[384 + dvc]) * eg;
        const float vnew = beta * (vs[dvc] - kS);
        float po = 0.f;
#pragma unroll
        for (int i = 0; i < 32; ++i) { S[i] = eg * S[i] + ks[dkg * 32 + i] * vnew; po += qs[dkg * 32 + i] * S[i]; }
        red2[dkg * 128 + dvc] = po;
        __syncthreads();
        float o = 0.f, so = 0.f;
        if (F.tid < 128) { o = red2[dvc] + red2[128 + dvc] + red2[256 + dvc] + red2[384 + dvc]; so = o * o; }
        const float ss = wave_sum(so, F.lane);
        if (F.lane == 0) wsum[F.wave] = ss;
        __syncthreads();
        if (F.tid < 128) { const float rstd = 1.f / sqrtf((wsum[0] + wsum[1]) * (1.f / HD) + EPS);
            const size_t off = row * BRW + u.hh * HD + dvc;
            stf(F.br() + off, o * rstd * gain[dvc] * ldf(F.zs() + off)); }
        __syncthreads();
    }
#pragma unroll
    for (int i = 0; i < 32; ++i) u.Sout[(size_t)(dkg * 32 + i) * HD + dvc] = S[i];
    __syncthreads();
}
__device__ __forceinline__ NGdn mk_gdn(Frame& F, int L, int u) {
    const int j = L >> 1; NGdn g; g.j = j;
    if (u < NB * NH) { const int b = u / NH, hh = u % NH; g.hh = hh; g.row0 = (size_t)b * SEQ; g.nT = SEQ; g.hist = nullptr; g.S0 = nullptr;
        g.Sout = F.out() + O_PGS + (((size_t)j * NB + b) * NH + hh) * HD * HD; }
    else { const int s = u - NB * NH, bs = s / NH, hh = s % NH; g.hh = hh; g.row0 = (size_t)MP + (size_t)bs * DS; g.nT = DS;
        g.hist = F.in(7) + ((size_t)j * DB + bs) * 3 * CONVCH; g.S0 = F.in(6) + (((size_t)j * DB + bs) * NH + hh) * HD * HD;
        g.Sout = F.out() + O_SGS + (((size_t)j * DB + bs) * NH + hh) * HD * HD; }
    return g;
}

__device__ __forceinline__ void p_mixer_naive(Frame& F, int L) {
    const bool gdn = L & 1;
    const int n_seq = gdn ? NB * NH + DB * NH : 0;
    const int n_fp = gdn ? 0 : NB * NH * (SEQ / 16);
    const int n_fs = gdn ? 0 : DB * NH;
    const int n_mp = NB * NMH * (SEQ / 16), n_ms = DB * NMH;
    const int total = n_seq + n_fp + n_fs + n_mp + n_ms;
    for (int u = F.bid; u < total; u += F.G) {
        int r = u;
        if (r < n_seq) { const NGdn g = mk_gdn(F, L, r); ngdn_unit(F, g); continue; }
        r -= n_seq;
        NAttn a;
        if (r < n_fp) { const int qt = (SEQ / 16 - 1) - r / (NB * NH), bh = r % (NB * NH); a = mk_fox_prompt(F, L, bh / NH, bh % NH, qt * 16, 16); }
        else if (r < n_fp + n_fs) { r -= n_fp; a = mk_fox_sample(F, L, r / NH, r % NH); }
        else if (r < n_fp + n_fs + n_mp) { r -= n_fp + n_fs; const int qt = r / (NB * NMH), bh = r % (NB * NMH); a = mk_mem_prompt(F, L, bh / NMH, bh % NMH, qt * 16, 16); }
        else { r -= n_fp + n_fs + n_mp; a = mk_mem_sample(F, L, r / NMH, r % NMH); }
        nattn_unit(F, a);
    }
}

__device__ __forceinline__ void p_gdn_naive(Frame& F, int L) {
    if (!(L & 1)) return;
    for (int u = F.bid; u < NB * NH + DB * NH; u += F.G) { const NGdn g = mk_gdn(F, L, u); ngdn_unit(F, g); }
}
#ifndef WGM_
#define WGM_ 4
#endif
namespace pg8 {
#define PG8_LAS __attribute__((address_space(3)))
constexpr int BM = 256, BK = 64, HALF = 128, HTB = HALF * BK * 2  , STAGE_BYTES = 8 * HTB, NXCD = 8, WGM = WGM_;

__host__ __device__ __forceinline__ int lds_byte(int r, int c) { const int st = (r >> 4) * 2 + (c >> 5), rr = r & 15, cc = c & 31, ob = rr * 64 + cc * 2; return st * 1024 + (ob ^ (((ob >> 9) & 1) << 5)); }
__host__ __device__ __forceinline__ void stage_rc(int b, int& R, int& C) { const int st = b / 1024, sb = b % 1024, swz = sb ^ (((sb >> 9) & 1) << 5); R = (st >> 1) * 16 + swz / 64; C = (st & 1) * 32 + (swz % 64) / 2; }
__host__ __device__ __forceinline__ int perm32(int rho) { const int n = rho >> 4, i = rho & 15; return 8 * (i >> 2) + 4 * n + (i & 3); }

struct Unit { int pm, pn, ks; };
struct Gemm { const bf16_t* A; const bf16_t* Bt; int M, N, K; };

struct StaticOrder {
    int nM, nN, nwg, G, c, wgm;
    __host__ __device__ void init(int M, int N, int G_, int c_, int wgm_ = WGM) { nM = M / BM; nN = N / BM; nwg = nM * nN; G = G_; c = c_; wgm = wgm_; }
    __host__ __device__ bool next(int i, Unit& u) const {
        const long L = (long)i * G + c; if (L >= nwg) return false;
        int wgid = (int)L; { const int q = nwg / NXCD, r = nwg % NXCD, xcd = wgid % NXCD, off = wgid / NXCD; wgid = (xcd < r ? xcd * (q + 1) : r * (q + 1) + (xcd - r) * q) + off; }
        const int nig = wgm * nN, gid = wgid / nig, fm = gid * wgm, gsz = (nM - fm) < wgm ? (nM - fm) : wgm;
        u.pm = fm + ((wgid % nig) % gsz); u.pn = (wgid % nig) / gsz; u.ks = -1; return true;
    }
    __device__ __forceinline__ void a_ready(const Unit&) const {}
    __device__ __forceinline__ void done(const Unit&) const {}
    __device__ __forceinline__ size_t koff(const Unit&) const { return 0; }
    __device__ __forceinline__ int nt(const Unit&, int ntf) const { return ntf; }
};

__device__ __forceinline__ unsigned cvt_pk_bf16(float lo, float hi) { unsigned r; asm volatile("v_cvt_pk_bf16_f32 %0, %1, %2" : "=v"(r) : "v"(lo), "v"(hi)); return r; }
template <class Epi, class Sched, bool ALIGN_EPI = false, bool SP2 = false>
__device__ __forceinline__ void gemm_phase(PG8_LAS unsigned char* lds, const Gemm g, const Sched& S, const Epi& E, int tid_in) {
    int tid_ = tid_in; asm volatile("" : "+v"(tid_));
    const int tid = tid_, wid = __builtin_amdgcn_readfirstlane(tid >> 6), lane = tid & 63, wr = wid >> 2, wc = wid & 3, fr = lane & 15, fq = lane >> 4;
    const int K = g.K, ntf = K / BK;
    unsigned voffA[2], voffB[2];
#pragma unroll
    for (int i = 0; i < 2; ++i) { int R, C; stage_rc(tid * 16 + i * 8192, R, C); const int Rb = Epi::PERM ? ((R & ~31) + perm32(R & 31)) : R;
        voffA[i] = (unsigned)(R * K + C) * 2u; voffB[i] = (unsigned)(Rb * K + C) * 2u; }
    const size_t kstep = (size_t)(BK * 2);
    const size_t hstep = (size_t)HALF * K * 2;
    const size_t tstep = 2 * hstep;
    const unsigned ldsw = (unsigned)wid * 1024u;
    const int aoff = lds_byte(wr * 64 + fr, fq * 8), boff = lds_byte(wc * 32 + fr, fq * 8);
#define PG8_SA(b, h) (((b) * 2 + (h)) * HTB)
#define PG8_SB(b, h) ((4 + (b) * 2 + (h)) * HTB)
#define PG8_STAGE(bufoff, gbase, voff) do { _Pragma("unroll") for (int _i = 0; _i < 2; ++_i) \
        __builtin_amdgcn_global_load_lds((const unsigned*)((const char*)(gbase) + (voff)[_i]), (PG8_LAS unsigned*)(lds + (bufoff) + ldsw + _i * 8192), 16, 0, 0); } while (0)
#define PG8_LDA(dst, b, h) do { _Pragma("unroll") for (int m = 0; m < 4; ++m) _Pragma("unroll") for (int k = 0; k < 2; ++k) dst[m][k] = *(const PG8_LAS bf16x8*)(lds + PG8_SA(b, h) + aoff + m * 2048 + k * 1024); } while (0)
#define PG8_LDB(dst, b, h) do { _Pragma("unroll") for (int n = 0; n < 2; ++n) _Pragma("unroll") for (int k = 0; k < 2; ++k) dst[n][k] = *(const PG8_LAS bf16x8*)(lds + PG8_SB(b, h) + boff + n * 2048 + k * 1024); } while (0)
#define PG8_MMA(ai, bj, At, Bt) do { __builtin_amdgcn_s_setprio(1); _Pragma("unroll") for (int m = 0; m < 4; ++m) _Pragma("unroll") for (int n = 0; n < 2; ++n) _Pragma("unroll") for (int k = 0; k < 2; ++k) \
        acc[ai][bj][m][n] = __builtin_amdgcn_mfma_f32_16x16x32_bf16(Bt[n][k], At[m][k], acc[ai][bj][m][n], 0, 0, 0); __builtin_amdgcn_s_setprio(0); } while (0)
#define PG8_WAIT_V(n) asm volatile("s_waitcnt vmcnt(" #n ")" ::: "memory")
#define PG8_WAIT_L(n) asm volatile("s_waitcnt lgkmcnt(" #n ")" ::: "memory")
#define PG8_BAR __builtin_amdgcn_s_barrier()
#define PG8_SCHED __builtin_amdgcn_sched_barrier(0)
    Unit cur, nxt; int ui = 0;
    if (!S.next(0, cur)) return;
    f32x4 acc[2][2][4][2];
#pragma unroll
    for (int a = 0; a < 2; ++a)
#pragma unroll
        for (int b = 0; b < 2; ++b)
#pragma unroll
            for (int m = 0; m < 4; ++m)
#pragma unroll
                for (int n = 0; n < 2; ++n) acc[a][b][m][n] = (f32x4){0.f, 0.f, 0.f, 0.f};
    bf16x8 At[4][2], B0[2][2], B1[2][2];
    const char* cA = (const char*)g.A + (size_t)cur.pm * tstep + S.koff(cur); const char* cB = (const char*)g.Bt + (size_t)cur.pn * tstep + S.koff(cur);
    int nt = S.nt(cur, ntf);
    S.a_ready(cur);
    if constexpr (SP2) {
        PG8_STAGE(PG8_SB(0, 0), cB, voffB); PG8_STAGE(PG8_SB(0, 1), cB + hstep, voffB); PG8_STAGE(PG8_SA(0, 0), cA, voffA); PG8_STAGE(PG8_SA(0, 1), cA + hstep, voffA);
        if (wr == 1) PG8_BAR;
        PG8_WAIT_V(2); PG8_BAR;
        PG8_STAGE(PG8_SB(1, 0), cB + kstep, voffB); PG8_STAGE(PG8_SA(1, 0), cA + kstep, voffA); PG8_STAGE(PG8_SB(1, 1), cB + hstep + kstep, voffB);
        PG8_WAIT_V(6); PG8_BAR;
    } else {
        PG8_STAGE(PG8_SB(0, 0), cB, voffB); PG8_STAGE(PG8_SA(0, 0), cA, voffA); PG8_STAGE(PG8_SB(0, 1), cB + hstep, voffB); PG8_STAGE(PG8_SA(0, 1), cA + hstep, voffA);
        if (wr == 1) PG8_BAR;
        PG8_WAIT_V(4); PG8_BAR;
        PG8_STAGE(PG8_SB(1, 0), cB + kstep, voffB); PG8_STAGE(PG8_SA(1, 0), cA + kstep, voffA); PG8_STAGE(PG8_SB(1, 1), cB + hstep + kstep, voffB);
        PG8_WAIT_V(6); PG8_BAR;
    }
    for (;;) {
        const bool has_next = S.next(ui + 1, nxt);
        const char* nA = has_next ? (const char*)g.A + (size_t)nxt.pm * tstep + S.koff(nxt) : cA; const char* nB = has_next ? (const char*)g.Bt + (size_t)nxt.pn * tstep + S.koff(nxt) : cB;
        for (int t = 0; t < nt; t += 2) {
            const bool last = (t == nt - 2);
            const char* a1 = cA + (size_t)(t + 1) * kstep;
            const char* a2 = last ? nA : cA + (size_t)(t + 2) * kstep; const char* b2 = last ? nB : cB + (size_t)(t + 2) * kstep;
            const char* a3 = a2 + kstep; const char* b3 = b2 + kstep;
            if (last && has_next) S.a_ready(nxt);
            if constexpr (SP2) {
            PG8_LDB(B0, 0, 0); PG8_LDB(B1, 0, 1); PG8_SCHED; PG8_LDA(At, 0, 0); PG8_STAGE(PG8_SA(1, 1), a1 + hstep, voffA);
            PG8_WAIT_V(8); PG8_WAIT_L(0); PG8_BAR; PG8_MMA(0, 0, At, B0); PG8_MMA(0, 1, At, B1); PG8_BAR; PG8_SCHED;
            PG8_LDA(At, 0, 1); PG8_STAGE(PG8_SB(0, 0), b2, voffB); PG8_STAGE(PG8_SB(0, 1), b2 + hstep, voffB); PG8_STAGE(PG8_SA(0, 0), a2, voffA);
            PG8_WAIT_V(8); PG8_WAIT_L(0); PG8_BAR; PG8_MMA(1, 0, At, B0); PG8_MMA(1, 1, At, B1); PG8_BAR; PG8_SCHED;
            PG8_LDB(B0, 1, 0); PG8_LDB(B1, 1, 1); PG8_SCHED; PG8_LDA(At, 1, 0); PG8_STAGE(PG8_SA(0, 1), a2 + hstep, voffA);
            PG8_WAIT_V(8); PG8_WAIT_L(0); PG8_BAR; PG8_MMA(0, 0, At, B0); PG8_MMA(0, 1, At, B1); PG8_BAR; PG8_SCHED;
            PG8_LDA(At, 1, 1); PG8_STAGE(PG8_SB(1, 0), b3, voffB); PG8_STAGE(PG8_SB(1, 1), b3 + hstep, voffB); PG8_STAGE(PG8_SA(1, 0), a3, voffA);
            PG8_WAIT_V(8); PG8_WAIT_L(0); PG8_BAR; PG8_MMA(1, 0, At, B0); PG8_MMA(1, 1, At, B1); PG8_BAR; PG8_SCHED;
            } else {
            PG8_LDB(B0, 0, 0); PG8_SCHED; PG8_LDA(At, 0, 0); PG8_STAGE(PG8_SA(1, 1), a1 + hstep, voffA);
            PG8_WAIT_L(8); PG8_BAR; PG8_WAIT_L(0); PG8_MMA(0, 0, At, B0); PG8_BAR; PG8_SCHED;
            PG8_LDB(B1, 0, 1); PG8_STAGE(PG8_SB(0, 0), b2, voffB);
            PG8_BAR; PG8_WAIT_L(0); PG8_MMA(0, 1, At, B1); PG8_BAR;
            PG8_LDA(At, 0, 1); PG8_STAGE(PG8_SA(0, 0), a2, voffA);
            PG8_BAR; PG8_WAIT_L(0); PG8_MMA(1, 0, At, B0); PG8_BAR; PG8_SCHED;
            PG8_STAGE(PG8_SB(0, 1), b2 + hstep, voffB);
            PG8_WAIT_V(6); PG8_BAR; PG8_MMA(1, 1, At, B1); PG8_BAR;
            PG8_LDB(B0, 1, 0); PG8_SCHED; PG8_LDA(At, 1, 0); PG8_STAGE(PG8_SA(0, 1), a2 + hstep, voffA);
            PG8_WAIT_L(8); PG8_BAR; PG8_WAIT_L(0); PG8_MMA(0, 0, At, B0); PG8_BAR; PG8_SCHED;
            PG8_LDB(B1, 1, 1); PG8_STAGE(PG8_SB(1, 0), b3, voffB);
            PG8_BAR; PG8_WAIT_L(0); PG8_MMA(0, 1, At, B1); PG8_BAR;
            PG8_LDA(At, 1, 1); PG8_STAGE(PG8_SA(1, 0), a3, voffA);
            PG8_BAR; PG8_WAIT_L(0); PG8_MMA(1, 0, At, B0); PG8_BAR; PG8_SCHED;
            PG8_STAGE(PG8_SB(1, 1), b3 + hstep, voffB);
            PG8_WAIT_V(6); PG8_BAR; PG8_MMA(1, 1, At, B1); PG8_BAR;
            }
        }
        if constexpr (ALIGN_EPI) { if (wr == 0) PG8_BAR; }
        if constexpr (!Epi::AFTER_DRAIN) { int l2_ = tid & 63; asm volatile("" : "+v"(l2_)); E(acc, cur, wr, wc, l2_ & 15, l2_ >> 4); S.done(cur); }
        if (!has_next) break;
#pragma unroll
        for (int a = 0; a < 2; ++a)
#pragma unroll
            for (int b = 0; b < 2; ++b)
#pragma unroll
                for (int m = 0; m < 4; ++m)
#pragma unroll
                    for (int n = 0; n < 2; ++n) acc[a][b][m][n] = (f32x4){0.f, 0.f, 0.f, 0.f};
        cur = nxt; cA = nA; cB = nB; ++ui; nt = S.nt(cur, ntf);
        if constexpr (ALIGN_EPI) { if (wr == 1) PG8_BAR; }
    }
    PG8_WAIT_V(0);
    if constexpr (!ALIGN_EPI) { if (wr == 0) PG8_BAR; }
    PG8_BAR;
    if constexpr (Epi::AFTER_DRAIN) { E.fused(acc, cur, wr, wc, fr, fq, lds, wid, lane); S.done(cur); }
#undef PG8_SA
#undef PG8_SB
#undef PG8_STAGE
#undef PG8_LDA
#undef PG8_LDB
#undef PG8_MMA
#undef PG8_WAIT_V
#undef PG8_WAIT_L
#undef PG8_BAR
#undef PG8_SCHED
}
}
__device__ __forceinline__ u32x4 pack8_bf16(f32x4 a, f32x4 b) {
    u32x4 w; w.x = pg8::cvt_pk_bf16(a[0], a[1]); w.y = pg8::cvt_pk_bf16(a[2], a[3]); w.z = pg8::cvt_pk_bf16(b[0], b[1]); w.w = pg8::cvt_pk_bf16(b[2], b[3]); return w;
}
struct EpiInProjV {
    static constexpr bool PERM = true, AFTER_DRAIN = false;
    int L; float* out; unsigned char* ws; const float* bfor; const float* alog; const float* dtb;
#define EPI_FOR_GROUPS(...) _Pragma("unroll") for (int ai = 0; ai < 2; ++ai) { _Pragma("unroll") for (int m = 0; m < 4; ++m) { const int r = row0 + ai * 128 + m * 16; \
        _Pragma("unroll") for (int bj = 0; bj < 2; ++bj) { const f32x4 v0 = acc[ai][bj][m][0], v1 = acc[ai][bj][m][1]; __VA_ARGS__ } asm volatile("" ::: "memory"); } }
    __device__ __forceinline__ void operator()(const f32x4 (&acc)[2][2][4][2], const pg8::Unit& u, int wr, int wc, int fr_, int fq_) const {
        int fr = fr_, fq = fq_; asm volatile("" : "+v"(fr), "+v"(fq));
        const int j = L >> 1; const bool gdn = (L & 1) != 0; const int pn = u.pn, pm = u.pm;
        bf16_t* qkv = (bf16_t*)(ws + WS_QKV); bf16_t* qm = (bf16_t*)(ws + WS_QM); bf16_t* zs = (bf16_t*)(ws + WS_ZS); float* ga = (float*)(ws + WS_GA); float* beta = (float*)(ws + WS_BETA);
        const int row0 = pm * 256 + wr * 64 + fr, cl = wc * 32 + 8 * fq;
        if (pn < 18) {
            bf16_t* qb = qkv + pn * 256 + cl;
            if (gdn || pn < 18) { EPI_FOR_GROUPS( *(u32x4*)(qb + (size_t)r * CONVCH + bj * 128) = pack8_bf16(v0, v1); ) }
            if (!gdn) {
                if (pn >= 6) {
                    const bool isv = pn >= 12; const int cc = pn * 256 + cl - (isv ? 2 * MIXW : MIXW);
                    float* ob = (pm < 64 ? out + (isv ? O_PFV : O_PFK) + (size_t)j * MP * MIXW : out + (isv ? O_SFV : O_SFK) + ((size_t)j * MS - MP) * MIXW) + cc;
                    EPI_FOR_GROUPS( float* o = ob + (size_t)r * MIXW + bj * 128; *(f32x4*)o = v0; *(f32x4*)(o + 4) = v1; )
                }
            } else if (pm == 31 || pm >= 63) {
                const int c0b = pn * 256 + cl;
                EPI_FOR_GROUPS( float* o = nullptr;
                    if (r < MP) { const int t = r & (SEQ - 1), b = r >> 13; if (t >= SEQ - 3) o = out + O_PGC + (((size_t)j * NB + b) * 3 + (t - (SEQ - 3))) * CONVCH + c0b + bj * 128; }
                    else { const int s = r - MP, l = s & 15, bs = s >> 4; if (l >= DS - 3) o = out + O_SGC + (((size_t)j * DB + bs) * 3 + (l - (DS - 3))) * CONVCH + c0b + bj * 128; }
                    if (o) { *(f32x4*)o = v0; *(f32x4*)(o + 4) = v1; } )
            }
        } else if (pn < 20) {
            bf16_t* qb = qm + (pn * 256 + cl - C_QM);
            EPI_FOR_GROUPS( *(u32x4*)(qb + (size_t)r * MEMW + bj * 128) = pack8_bf16(v0, v1); )
        } else if (pn < 28) {
            bf16_t* zb = zs + (pn * 256 + cl - C_Z);
            EPI_FOR_GROUPS( f32x4 s0; f32x4 s1;
                _Pragma("unroll") for (int e = 0; e < 4; ++e) { s0[e] = siluf(v0[e]); s1[e] = siluf(v1[e]); }
                *(u32x4*)(zb + (size_t)r * BRW + bj * 128) = pack8_bf16(s0, s1); )
        } else if (cl < 2 * NH) {
            EPI_FOR_GROUPS( if (bj == 0) {
                _Pragma("unroll") for (int e = 0; e < 8; ++e) { const int c = cl + e; const float v = e < 4 ? v0[e & 3] : v1[e & 3];
                    if (!gdn) {
                        if (c < NH) { const float lf = logsigmoidf(v + bfor[j * NH + c]);
                            if (r < MP) out[O_PFL + ((size_t)j * MP + r) * NH + c] = lf; else out[O_SFL + ((size_t)j * MS + (r - MP)) * NH + c] = lf; }
                    } else {
                        if (c < NH) ga[(size_t)r * NH + c] = -__expf(alog[j * NH + c]) * softplusf(v + dtb[j * NH + c]);
                        else if (c < 2 * NH) beta[(size_t)r * NH + (c - NH)] = sigmoidf_(v);
                    } } } )
        }
    }
#undef EPI_FOR_GROUPS
};
__device__ __forceinline__ EpiInProjV mk_epi_inproj_v(const Frame& F, int L) {
    EpiInProjV e; e.L = L; e.out = F.out(); e.ws = F.ws(); e.bfor = F.in(14); e.alog = F.in(17); e.dtb = F.in(18); return e;
}
struct EpiOutProjV {
    static constexpr bool PERM = true, AFTER_DRAIN = false;
    int L; float* out; const float* xp; const float* xs; float* part;
    __device__ __forceinline__ void operator()(const f32x4 (&acc)[2][2][4][2], const pg8::Unit& u, int wr, int wc, int fr_, int fq_) const {
        int fr = fr_, fq = fq_; asm volatile("" : "+v"(fr), "+v"(fq));
        const int row0 = u.pm * 256 + wr * 64 + fr, cl = u.pn * 256 + wc * 32 + 8 * fq;
        if (u.ks < 0) {
#pragma unroll
            for (int ai = 0; ai < 2; ++ai) {
                f32x4 xo[4][2][2];
#pragma unroll
                for (int m = 0; m < 4; ++m) { const int r = row0 + ai * 128 + m * 16;
                    const float* xp_ = L == 0 ? (r < MP ? xp + (size_t)r * DM : xs + (size_t)(r - MP) * DM) : out + (size_t)r * DM;
#pragma unroll
                    for (int bj = 0; bj < 2; ++bj) { xo[m][bj][0] = *(const f32x4*)(xp_ + cl + bj * 128); xo[m][bj][1] = *(const f32x4*)(xp_ + cl + bj * 128 + 4); } }
                asm volatile("" ::: "memory");
#pragma unroll
                for (int m = 0; m < 4; ++m) { float* xn = out + (size_t)(row0 + ai * 128 + m * 16) * DM;
#pragma unroll
                    for (int bj = 0; bj < 2; ++bj) { *(f32x4*)(xn + cl + bj * 128) = xo[m][bj][0] + acc[ai][bj][m][0]; *(f32x4*)(xn + cl + bj * 128 + 4) = xo[m][bj][1] + acc[ai][bj][m][1]; } }
                asm volatile("" ::: "memory");
            }
        } else {
            const int rl0 = row0 - MP + u.ks * MS;
#pragma unroll
            for (int ai = 0; ai < 2; ++ai)
#pragma unroll
                for (int m = 0; m < 4; ++m) {
                    float* xn = part + (size_t)(rl0 + ai * 128 + m * 16) * DM;
#pragma unroll
                    for (int bj = 0; bj < 2; ++bj) { const int c0 = cl + bj * 128; *(f32x4*)(xn + c0) = acc[ai][bj][m][0]; *(f32x4*)(xn + c0 + 4) = acc[ai][bj][m][1]; }
                }
        }
    }
};
struct EpiMemKVV {
    static constexpr bool PERM = true, AFTER_DRAIN = false;
    float* out;
    __device__ __forceinline__ void operator()(const f32x4 (&acc)[2][2][4][2], const pg8::Unit& u, int wr, int wc, int fr_, int fq_) const {
        int fr = fr_, fq = fq_; asm volatile("" : "+v"(fr), "+v"(fq));
        const int L = u.pm >> 1, row0 = (u.pm & 1) * 256 + wr * 64 + fr, cl = (u.pn & 3) * 256 + wc * 32 + 8 * fq;
#pragma unroll
        for (int ai = 0; ai < 2; ++ai)
#pragma unroll
            for (int m = 0; m < 4; ++m) {
                const int r = row0 + ai * 128 + m * 16;
#pragma unroll
                for (int bj = 0; bj < 2; ++bj) { const int c0 = cl + bj * 128;
                    float* o = c0 < MEMW ? out + O_PMK + ((size_t)L * 512 + r) * MEMW + c0 : out + O_PMV + ((size_t)L * 512 + r) * MEMW + (c0 - MEMW);
                    *(f32x4*)o = acc[ai][bj][m][0]; *(f32x4*)(o + 4) = acc[ai][bj][m][1]; }
            }
    }
};
struct MemKvOrder {
    int G, c;
    __device__ __forceinline__ bool next(int i, pg8::Unit& u) const {
        const int idx = i * G + c; if (idx < 0 || idx >= 32) return false;
        const int L = idx >> 3, rem = idx & 7; u.pm = 2 * L + (rem >> 2); u.pn = 4 * L + (rem & 3); u.ks = -1; return true;
    }
    __device__ __forceinline__ void a_ready(const pg8::Unit&) const {}
    __device__ __forceinline__ void done(const pg8::Unit&) const {}
    __device__ __forceinline__ size_t koff(const pg8::Unit&) const { return 0; }
    __device__ __forceinline__ int nt(const pg8::Unit&, int ntf) const { return ntf; }
};
#ifndef OP_SPLIT
#define OP_SPLIT 0
#endif
#ifndef OP_WGM
#define OP_WGM 4
#endif
struct OutProjOrder {
    pg8::StaticOrder P; int G, c;
    __device__ __forceinline__ void init(int G_, int c_) { P.init(OP_SPLIT ? MP : MR, DM, G_, c_, OP_WGM); G = G_; c = c_; }
    __device__ __forceinline__ bool next(int i, pg8::Unit& u) const {
        if (!OP_SPLIT) return P.next(i, u);
        const int idx = i * G + c; if (idx < 512) return P.next(i, u);
        const int sub = idx - 512; if (sub >= 16 * OP_KS) return false;
        const int tile = sub / OP_KS; u.pm = 64 + (tile >> 3); u.pn = tile & 7; u.ks = sub % OP_KS; return true;
    }
    __device__ __forceinline__ void a_ready(const pg8::Unit&) const {}
    __device__ __forceinline__ void done(const pg8::Unit&) const {}
    __device__ __forceinline__ size_t koff(const pg8::Unit& u) const { return u.ks < 0 ? 0 : (size_t)u.ks * (BRW / OP_KS) * 2; }
    __device__ __forceinline__ int nt(const pg8::Unit& u, int ntf) const { return u.ks < 0 ? ntf : ntf / OP_KS; }
};
namespace att {
constexpr int NW = 8, QBLK = 32, KVBLK = 64, QB = NW * QBLK, D = 128;
constexpr int SHM_V = KVBLK * D * 2, SHM_K = KVBLK * D * 2;
constexpr int OFF_V = 0, OFF_K = 2 * SHM_V, OFF_WS = 2 * SHM_V + 2 * SHM_K, OFF_G = OFF_WS + NW * 64 * 4, OFF_Q = OFF_G + 8192 * 4, LDS_BYTES = OFF_Q + 64;
constexpr float SCALE = 0.08838834764831845f, LOG2E = 1.4426950408889634f, C2 = LOG2E * SCALE, THR2 = 8.f * LOG2E;
constexpr unsigned WINF = 0x7fffffffu;

#define KSWZ(row, colB) ((row) * 256 + ((colB) ^ (((row) & 7) << 4)))
#define SBAR() __builtin_amdgcn_sched_barrier(0)
__device__ __forceinline__ int v_st(int k, int c) { const int kk = (k & ~0xC) | ((k & 4) << 1) | ((k & 8) >> 1); return ((kk >> 3) * 4 + (c >> 5)) * 512 + ((kk & 7) * 32 + (c & 31)) * 2; }
__device__ __forceinline__ int v_rd_base(int lane) { return ((lane & 3) << 3) | (((lane >> 2) & 3) << 6) | (((lane >> 4) & 1) << 5) | (((lane >> 5) & 1) << 8); }
constexpr int v_rd_off(int d0, int ks, int half) { return d0 * 512 + ks * 4096 + half * 2048; }
__device__ __forceinline__ int crow(int r, int hi) { return (r & 3) + 8 * (r >> 2) + 4 * hi; }
__device__ __forceinline__ unsigned cvtpk(float lo, float hi) { unsigned r; asm volatile("v_cvt_pk_bf16_f32 %0, %1, %2" : "=v"(r) : "v"(lo), "v"(hi)); return r; }
__device__ __forceinline__ bf16x8 pack8(f32x4 a, f32x4 b) { u32x4 w = {cvtpk(a[0], a[1]), cvtpk(a[2], a[3]), cvtpk(b[0], b[1]), cvtpk(b[2], b[3])}; return __builtin_bit_cast(bf16x8, w); }

__device__ __forceinline__ void mask_tile(f32x16& p0, f32x16& p1, int dq, unsigned W) {
    const float NEG = -__builtin_inff();
#pragma unroll
    for (int r = 0; r < 16; ++r) { const int c = (r & 3) + 8 * (r >> 2);
        if ((unsigned)(dq - c) >= W) p0[r] = NEG;
        if ((unsigned)(dq - c - 32) >= W) p1[r] = NEG; }
}
__device__ __forceinline__ void partialSM(f32x16& p0, f32x16& p1, const LAS float* gl, int hi, float& m_reg, float& mn, float& alpha) {
#pragma unroll
    for (int g = 0; g < 4; ++g) { const f32x4 b0 = *(const LAS f32x4*)(gl + 8 * g + 4 * hi), b1 = *(const LAS f32x4*)(gl + 32 + 8 * g + 4 * hi);
#pragma unroll
        for (int e = 0; e < 4; ++e) { p0[4 * g + e] = fmaf(p0[4 * g + e], C2, b0[e]); p1[4 * g + e] = fmaf(p1[4 * g + e], C2, b1[e]); } }
    float pmax = p0[0];
#pragma unroll
    for (int r = 1; r < 16; ++r) pmax = fmaxf(pmax, p0[r]);
#pragma unroll
    for (int r = 0; r < 16; ++r) pmax = fmaxf(pmax, p1[r]);
    { auto rr = __builtin_amdgcn_permlane32_swap(__float_as_uint(pmax), __float_as_uint(pmax), false, false);
      pmax = fmaxf(__uint_as_float(rr[0]), __uint_as_float(rr[1])); }
    if (__builtin_expect(__all((pmax - m_reg) <= THR2), 1)) { mn = m_reg; alpha = 1.f; }
    else { mn = fmaxf(m_reg, pmax); alpha = __builtin_amdgcn_exp2f(m_reg - mn); m_reg = mn; }
#pragma unroll
    for (int r = 0; r < 16; ++r) { p0[r] = __builtin_amdgcn_exp2f(p0[r] - mn); p1[r] = p1[r] - mn; }
}
__device__ __forceinline__ void finishSM(f32x16& p0, f32x16& p1, float alpha, float& l_reg, bf16x8& pa0, bf16x8& pa1, bf16x8& pa2, bf16x8& pa3) {
#pragma unroll
    for (int r = 0; r < 16; ++r) p1[r] = __builtin_amdgcn_exp2f(p1[r]);
    float ps = 0;
#pragma unroll
    for (int r = 0; r < 16; ++r) ps += p0[r];
#pragma unroll
    for (int r = 0; r < 16; ++r) ps += p1[r];
    { auto rr = __builtin_amdgcn_permlane32_swap(__float_as_uint(ps), __float_as_uint(ps), false, false);
      ps = __uint_as_float(rr[0]) + __uint_as_float(rr[1]); }
    l_reg = l_reg * alpha + ps;
#define PK4(P, B_, OUT) do { unsigned a0 = cvtpk(P[B_+0], P[B_+1]), a1 = cvtpk(P[B_+2], P[B_+3]);                          \
        unsigned b0 = cvtpk(P[B_+4], P[B_+5]), b1 = cvtpk(P[B_+6], P[B_+7]);                                             \
        auto r0 = __builtin_amdgcn_permlane32_swap(a0, b0, false, false); auto r1 = __builtin_amdgcn_permlane32_swap(a1, b1, false, false); \
        u32x4 w = {r0[0], r1[0], r0[1], r1[1]}; OUT = __builtin_bit_cast(bf16x8, w); } while (0)
    PK4(p0, 0, pa0); PK4(p0, 8, pa1); PK4(p1, 0, pa2); PK4(p1, 8, pa3);
#undef PK4
}
template <int KB>
__device__ __forceinline__ void qkt(f32x16& p0, f32x16& p1, const LAS char* K_lds, int r32, int hi, const bf16x8* qr) {
    p0 = f32x16{}; p1 = f32x16{};
    const LAS char* kb[4];
#pragma unroll
    for (int dd = 0; dd < 4; ++dd) kb[dd] = K_lds + KB * SHM_K + KSWZ(r32, (dd * 16 + hi * 8) * 2);
#pragma unroll
    for (int d0 = 0; d0 < 8; ++d0) { const LAS char* a = kb[d0 & 3] + (d0 >> 2) * 128;
        const bf16x8 b0 = *(const LAS bf16x8*)(a);
        const bf16x8 b1 = *(const LAS bf16x8*)(a + 32 * 256);
        p0 = __builtin_amdgcn_mfma_f32_32x32x16_bf16(b0, qr[d0], p0, 0, 0, 0);
        p1 = __builtin_amdgcn_mfma_f32_32x32x16_bf16(b1, qr[d0], p1, 0, 0, 0); }
}
template <int VB>
__device__ __forceinline__ void pv_tile(f32x16* o, int vb0, bf16x8 pa0, bf16x8 pa1, bf16x8 pa2, bf16x8 pa3) {
#define TRRD(dst, off) asm volatile("ds_read_b64_tr_b16 %0, %1 offset:%2" : "=&v"(dst) : "v"(vb0), "i"(off) : "memory")
#define PV_D0(d0) do { s16x4 l0, l1, l2, l3, h0, h1, h2, h3; constexpr int b_ = VB * SHM_V + v_rd_off(d0, 0, 0); \
        TRRD(l0, b_); TRRD(h0, b_ + 2048); TRRD(l1, b_ + 4096); TRRD(h1, b_ + 6144); TRRD(l2, b_ + 8192); TRRD(h2, b_ + 10240); TRRD(l3, b_ + 12288); TRRD(h3, b_ + 14336); \
        asm volatile("s_waitcnt lgkmcnt(0)" ::: "memory"); SBAR(); \
        o[d0] = __builtin_amdgcn_mfma_f32_32x32x16_bf16(pa0, (bf16x8){l0[0], l0[1], l0[2], l0[3], h0[0], h0[1], h0[2], h0[3]}, o[d0], 0, 0, 0);   \
        o[d0] = __builtin_amdgcn_mfma_f32_32x32x16_bf16(pa1, (bf16x8){l1[0], l1[1], l1[2], l1[3], h1[0], h1[1], h1[2], h1[3]}, o[d0], 0, 0, 0);   \
        o[d0] = __builtin_amdgcn_mfma_f32_32x32x16_bf16(pa2, (bf16x8){l2[0], l2[1], l2[2], l2[3], h2[0], h2[1], h2[2], h2[3]}, o[d0], 0, 0, 0);   \
        o[d0] = __builtin_amdgcn_mfma_f32_32x32x16_bf16(pa3, (bf16x8){l3[0], l3[1], l3[2], l3[3], h3[0], h3[1], h3[2], h3[3]}, o[d0], 0, 0, 0); } while (0)
    PV_D0(0); PV_D0(1); PV_D0(2); PV_D0(3);
#undef PV_D0
#undef TRRD
}

struct Ref {
    const bf16_t* Q; const float* K1; const float* V1; const float* K2; const float* V2; const float* G; bf16_t* O;
    int q_stride, kv_stride;
    int kvb16;
    int jsw;
    int P0;
    int skv;
    int nvalid;
    float gref;
};
struct Next { const bf16_t* Q; const float* K1; const float* V1; int q_stride, kv_stride, nvalid, kvb16; };
__device__ __forceinline__ Next next_of(const Ref& r) { Next n; n.Q = r.Q; n.K1 = r.K1; n.V1 = r.V1; n.q_stride = r.q_stride; n.kv_stride = r.kv_stride; n.nvalid = r.nvalid; n.kvb16 = r.kvb16; return n; }
struct Seam { bf16x8 qr[8]; f32x4 sf0, sf1, sf2, sf3; };

#define VMW() asm volatile("s_waitcnt vmcnt(0)" ::: "memory")
#define VMWN(n) asm volatile("s_waitcnt vmcnt(%0)" :: "i"(n) : "memory")
#define A_TID(v_) int v_ = tid; asm volatile("" : "+v"(v_))
#define A_KOFF(str_, b16_) A_TID(t2_); const int esh_ = (b16_) ? 1 : 2; const unsigned koff0 = ((unsigned)(t2_ >> 4) * (unsigned)(str_) + (unsigned)((t2_ & 15) * 8)) << esh_, koff1 = koff0 + ((32u * (unsigned)(str_)) << esh_)
#define A_LD4(p_) do { if (b16q_) { S.sf0 = *(const f32x4*)(p_ + koff0); S.sf2 = *(const f32x4*)(p_ + koff1); } \
        else { S.sf0 = *(const f32x4*)(p_ + koff0); S.sf1 = *(const f32x4*)(p_ + koff0 + 16); S.sf2 = *(const f32x4*)(p_ + koff1); S.sf3 = *(const f32x4*)(p_ + koff1 + 16); } } while (0)
#define A_SLOAD(R_, WHICH, t_) do { constexpr bool b16q_ = B16; A_KOFF((R_).kv_stride, b16q_); \
        const char* p_ = (const char*)(((t_) < (R_).jsw) ? (R_).WHICH##1 : (R_).WHICH##2) + (((size_t)((t_) * KVBLK) * (size_t)(R_).kv_stride) << esh_); A_LD4(p_); } while (0)
#define A_SLOADN(N_, WHICH) do { constexpr bool b16q_ = B16; A_KOFF((N_).kv_stride, b16q_); const char* p_ = (const char*)(N_).WHICH; A_LD4(p_); } while (0)
#define A_SLOADH(R_, t_) do { A_KOFF((R_).kv_stride, true); const size_t tb_ = ((size_t)((t_) * KVBLK) * (size_t)(R_).kv_stride) << 1; const char* pk_ = (const char*)(R_).K1 + tb_; const char* pv_ = (const char*)(R_).V1 + tb_; \
        S.sf0 = *(const f32x4*)(pk_ + koff0); S.sf2 = *(const f32x4*)(pk_ + koff1); S.sf1 = *(const f32x4*)(pv_ + koff0); S.sf3 = *(const f32x4*)(pv_ + koff1); } while (0)
#define A_SWRITE_KH(bf) do { A_TID(t3_); const int sr_ = t3_ >> 4, kws = KSWZ(sr_, (t3_ & 15) * 16); *(LAS bf16x8*)(K_lds + (bf) * SHM_K + kws) = __builtin_bit_cast(bf16x8, S.sf0); *(LAS bf16x8*)(K_lds + (bf) * SHM_K + kws + 32 * 256) = __builtin_bit_cast(bf16x8, S.sf2); } while (0)
#define A_SWRITE_VH(bf) do { A_TID(t4_); const int sr_ = t4_ >> 4, sc_ = (t4_ & 15) * 8, vst0 = v_st(sr_, sc_), vst1 = v_st(32 + sr_, sc_); *(LAS bf16x8*)(V_lds + (bf) * SHM_V + vst0) = __builtin_bit_cast(bf16x8, S.sf1); *(LAS bf16x8*)(V_lds + (bf) * SHM_V + vst1) = __builtin_bit_cast(bf16x8, S.sf3); } while (0)
#define A_PK(lo_, hi_, b16_) ((b16_) ? __builtin_bit_cast(bf16x8, lo_) : pack8(lo_, hi_))
#define A_SWRITE_K(bf, b16_) do { A_TID(t3_); const int sr_ = t3_ >> 4, kws = KSWZ(sr_, (t3_ & 15) * 16); *(LAS bf16x8*)(K_lds + (bf) * SHM_K + kws) = A_PK(S.sf0, S.sf1, b16_); *(LAS bf16x8*)(K_lds + (bf) * SHM_K + kws + 32 * 256) = A_PK(S.sf2, S.sf3, b16_); } while (0)
#define A_SWRITE_V(bf, b16_) do { A_TID(t4_); const int sr_ = t4_ >> 4, sc_ = (t4_ & 15) * 8, vst0 = v_st(sr_, sc_), vst1 = v_st(32 + sr_, sc_); *(LAS bf16x8*)(V_lds + (bf) * SHM_V + vst0) = A_PK(S.sf0, S.sf1, b16_); *(LAS bf16x8*)(V_lds + (bf) * SHM_V + vst1) = A_PK(S.sf2, S.sf3, b16_); } while (0)

template <bool B16>
__device__ __forceinline__ void attn_prime(const Ref& cur, LAS char* lds, Seam& S, int tid) {
    const int wid = __builtin_amdgcn_readfirstlane(tid >> 6), lane = tid & 63, r32 = lane & 31, hi = lane >> 5;
    LAS char* K_lds = lds + OFF_K;
    int qrow = wid * QBLK + r32; qrow = qrow < cur.nvalid ? qrow : cur.nvalid - 1;
#pragma unroll
    for (int d0 = 0; d0 < 8; ++d0) S.qr[d0] = *(const bf16x8*)(cur.Q + (size_t)qrow * cur.q_stride + d0 * 16 + hi * 8);
    if constexpr (B16) { A_SLOADH(cur, 0); VMW(); A_SWRITE_KH(0); }
    else { A_SLOAD(cur, K, 0); VMW(); A_SWRITE_K(0, B16); SBAR(); A_SLOAD(cur, V, 0); }
    __syncthreads();
}
template <bool B16>
__device__ __forceinline__ void attn_block(const Ref& cur, const Next& nxt, LAS char* lds, Seam& S, int tid) {
    const int wid = __builtin_amdgcn_readfirstlane(tid >> 6), lane = tid & 63, r32 = lane & 31, hi = lane >> 5;
    int j_hi = (cur.P0 + QB - 1) / KVBLK + 1; if (j_hi > cur.skv / KVBLK) j_hi = cur.skv / KVBLK;
    const int NT = j_hi;
    const bool act = wid * QBLK < cur.nvalid;
    const int qlo = cur.P0 + wid * QBLK, qm = qlo + r32 - 4 * hi;
    LAS char* V_lds = lds + OFF_V; LAS char* K_lds = lds + OFF_K; LAS float* G_lds = (LAS float*)(lds + OFF_G);
    LAS float* ws = (LAS float*)(lds + OFF_WS) + wid * 64; LAS float* li_l = ws; LAS float* al_l = ws + 32;
    float m_reg = -1e30f, l_reg = 0; f32x16 o[4] = {};
    const int vb0 = (int)(unsigned)(size_t)V_lds + v_rd_base(lane);
#define RESC(a) do { if (__any((a) < 1.f)) { if (hi == 0) al_l[r32] = (a); asm volatile("s_waitcnt lgkmcnt(0)" ::: "memory");              \
                     _Pragma("unroll") for (int d_ = 0; d_ < 4; ++d_) { _Pragma("unroll") for (int r = 0; r < 16; ++r) o[d_][r] *= al_l[crow(r, hi)]; } } } while (0)
#define MASKT(P0_, P1_, t) do { const int kb_ = (t) * KVBLK; if (kb_ + KVBLK - 1 > qlo) mask_tile(P0_, P1_, qm - kb_, WINF); } while (0)
    f32x16 pA0, pA1, pB0, pB1; float mnA, mnB, alA, alB; bf16x8 pa0, pa1, pa2, pa3;
    { A_TID(t5_); for (int i = t5_ * 4; i < NT * KVBLK; i += 2048) { const f32x4 g = *(const f32x4*)((const char*)cur.G + (unsigned)i * 4u); *(LAS f32x4*)(G_lds + i) = (cur.gref - g) * LOG2E; } }
    constexpr bool cb16 = B16;
    if constexpr (B16) {
        A_SWRITE_VH(0); SBAR(); __syncthreads();
        if (NT > 1) { A_SLOADH(cur, 1); }
        SBAR(); if (act) qkt<0>(pA0, pA1, K_lds, r32, hi, S.qr);
        if (act) { MASKT(pA0, pA1, 0); partialSM(pA0, pA1, G_lds, hi, m_reg, mnA, alA); }
        if (NT > 1) { VMW(); A_SWRITE_KH(1); A_SWRITE_VH(1); }
    } else {
    VMW(); A_SWRITE_V(0, cb16); SBAR(); __syncthreads();
    if (NT > 1) { A_SLOAD(cur, K, 1); }
    SBAR(); if (act) qkt<0>(pA0, pA1, K_lds, r32, hi, S.qr);
    if (NT > 1) { VMW(); A_SWRITE_K(1, cb16); SBAR(); A_SLOAD(cur, V, 1); }
    if (act) { MASKT(pA0, pA1, 0); partialSM(pA0, pA1, G_lds, hi, m_reg, mnA, alA); }
    if (NT > 1) { VMW(); A_SWRITE_V(1, cb16); SBAR(); if (NT > 2) { A_SLOAD(cur, K, 2); } }
    }
    __syncthreads();
#define HALF_STEP(PX0, PX1, mnX, alX, PY0, PY1, alY, t, KB, VB, SB) do {                                                      \
        SBAR(); if (act) { qkt<KB>(PX0, PX1, K_lds, r32, hi, S.qr);                                                           \
        finishSM(PY0, PY1, alY, l_reg, pa0, pa1, pa2, pa3); } SBAR();                                                           \
        if ((t) + 1 < NT) { if constexpr (B16) { A_SLOADH(cur, (t) + 1); SBAR(); } else { VMW(); A_SWRITE_K(SB, cb16); SBAR(); A_SLOAD(cur, V, (t) + 1); SBAR(); } }       \
        if (act) { pv_tile<VB>(o, vb0, pa0, pa1, pa2, pa3); MASKT(PX0, PX1, (t)); partialSM(PX0, PX1, G_lds + (t) * 64, hi, m_reg, mnX, alX); } \
        __syncthreads();                                                                                                      \
        if ((t) + 1 < NT) { if constexpr (B16) { VMW(); A_SWRITE_KH(SB); A_SWRITE_VH(SB); } else { VMW(); A_SWRITE_V(SB, cb16); SBAR(); if ((t) + 2 < NT) { A_SLOAD(cur, K, (t) + 2); } } } \
        if (act) RESC(alX); __syncthreads(); } while (0)
    for (int t = 1; t + 1 < NT; t += 2) {
        HALF_STEP(pB0, pB1, mnB, alB, pA0, pA1, alA, t, 1, 0, 0);
        HALF_STEP(pA0, pA1, mnA, alA, pB0, pB1, alB, t + 1, 0, 1, 1);
    }
    const bool even = (NT & 1) == 0;
    if (even && act) { SBAR(); qkt<1>(pB0, pB1, K_lds, r32, hi, S.qr); SBAR(); }
    { if constexpr (B16) { A_SLOADH(nxt, 0); } else { A_SLOADN(nxt, K1); } SBAR();
      int qrow = wid * QBLK + r32; qrow = qrow < nxt.nvalid ? qrow : nxt.nvalid - 1;
#pragma unroll
      for (int d0 = 0; d0 < 8; ++d0) S.qr[d0] = *(const bf16x8*)(nxt.Q + (size_t)qrow * nxt.q_stride + d0 * 16 + hi * 8); }
    SBAR();
    if (act) { finishSM(pA0, pA1, alA, l_reg, pa0, pa1, pa2, pa3); SBAR();
    pv_tile<0>(o, vb0, pa0, pa1, pa2, pa3); }
    if (even) { if (act) { MASKT(pB0, pB1, NT - 1); partialSM(pB0, pB1, G_lds + (NT - 1) * 64, hi, m_reg, mnB, alB); } __syncthreads(); if (act) { RESC(alB);
        finishSM(pB0, pB1, alB, l_reg, pa0, pa1, pa2, pa3); SBAR(); pv_tile<1>(o, vb0, pa0, pa1, pa2, pa3); } }
    SBAR(); VMWN(8); if constexpr (B16) { A_SWRITE_KH(0); SBAR(); } else { A_SWRITE_K(0, B16); SBAR(); A_SLOADN(nxt, V1); SBAR(); }
    if (hi == 0) li_l[r32] = l_reg; asm volatile("s_waitcnt lgkmcnt(0)" ::: "memory");
    float rli[16];
#pragma unroll
    for (int r = 0; r < 16; ++r) rli[r] = __builtin_amdgcn_rcpf(li_l[crow(r, hi)]);
#pragma unroll
    for (int r = 0; r < 16; ++r) { const int orow = wid * QBLK + crow(r, hi); const bool ok = orow < cur.nvalid && (r32 & 1) == 0;
        const size_t ro = (size_t)orow * BRW; const bf16_t* Zp = (const bf16_t*)((const char*)cur.O - WS_BR + WS_ZS);
#pragma unroll
        for (int d0 = 0; d0 < 4; ++d0) { const float v = o[d0][r] * rli[r]; const float vn = __int_as_float(__builtin_amdgcn_update_dpp(0, __float_as_int(v), 0xB1, 0xF, 0xF, false));
            if (ok) { const unsigned zz = *(const unsigned*)(Zp + ro + d0 * 32 + r32);
                *(unsigned*)(cur.O + ro + d0 * 32 + r32) = cvtpk(v * __uint_as_float(zz << 16), vn * __uint_as_float(zz & 0xffff0000u)); } } }
    __syncthreads();
#undef RESC
#undef MASKT
#undef HALF_STEP
}
#undef VMW
#undef VMWN
}

__device__ __forceinline__ int attn_total_items(int L) { return (L & 1) ? (NB * NMH * (SEQ / 256) + DB * NMH) : (NB * NH * (SEQ / 256) + DB * NH + NB * NMH * (SEQ / 256) + DB * NMH); }
__device__ __forceinline__ att::Ref attn_item(const Frame& F, int L, int idx) {
    const int j = L >> 1; att::Ref a;
    const int n_fp = (L & 1) ? 0 : NB * NH * (SEQ / 256), n_fs = (L & 1) ? 0 : DB * NH, n_mp = NB * NMH * (SEQ / 256);
    float* out = F.out(); const bf16_t* qkv = (const bf16_t*)F.qkv(); const bf16_t* qm = (const bf16_t*)F.qm(); bf16_t* br = (bf16_t*)F.br();
    if (idx < n_fp) {
        const int qb = (SEQ / 256 - 1) - idx / (NB * NH), bh = idx % (NB * NH), b = bh / NH, hh = bh % NH; const size_t r0 = (size_t)b * SEQ + (size_t)qb * 256;
        a.Q = qkv + r0 * CONVCH + hh * HD; a.q_stride = CONVCH;
        a.K1 = (const float*)(qkv + (size_t)b * SEQ * CONVCH + MIXW + hh * HD); a.V1 = (const float*)(qkv + (size_t)b * SEQ * CONVCH + 2 * MIXW + hh * HD); a.K2 = a.K1; a.V2 = a.V1;
        a.kv_stride = CONVCH; a.kvb16 = 1; a.jsw = 1 << 20; a.P0 = qb * 256; a.skv = SEQ; a.nvalid = 256;
        a.G = F.fp() + ((size_t)b * NH + hh) * SEQ; a.gref = __hip_atomic_load(a.G + qb * 256, __ATOMIC_RELAXED, __HIP_MEMORY_SCOPE_AGENT);
        { const float qn2 = __hip_atomic_load((const float*)(F.ws() + WS_QN) + bh * 32 + qb, __ATOMIC_RELAXED, __HIP_MEMORY_SCOPE_AGENT);
          const float kn2 = __uint_as_float(__hip_atomic_load(F.ctl() + CW_KN + L * 32 + bh, __ATOMIC_RELAXED, __HIP_MEMORY_SCOPE_AGENT));
          const float thr = a.gref + (160.f + 2.f * sqrtf(qn2) * sqrtf(kn2) * att::C2) * (1.f / att::LOG2E);
          const int t0 = 2 * F.lane, npast = 4 * qb;
          const float f0 = t0 < npast ? __hip_atomic_load(a.G + 64 * t0 + 63, __ATOMIC_RELAXED, __HIP_MEMORY_SCOPE_AGENT) : -3.0e38f;
          const float f1 = t0 + 1 < npast ? __hip_atomic_load(a.G + 64 * (t0 + 1) + 63, __ATOMIC_RELAXED, __HIP_MEMORY_SCOPE_AGENT) : -3.0e38f;
          const int j_lo = __builtin_popcountll(__ballot(f0 > thr)) + __builtin_popcountll(__ballot(f1 > thr));
          a.K1 = (const float*)((const char*)a.K1 + (size_t)j_lo * 64 * CONVCH * 2); a.V1 = (const float*)((const char*)a.V1 + (size_t)j_lo * 64 * CONVCH * 2); a.K2 = a.K1; a.V2 = a.V1; a.G += j_lo * 64; a.P0 -= j_lo * 64; a.skv -= j_lo * 64; }
        a.O = br + r0 * BRW + hh * HD;
    } else if (idx < n_fp + n_fs) {
        const int s = idx - n_fp, bs = s / NH, hh = s % NH; const size_t r0 = (size_t)MP + (size_t)bs * DS;
        a.Q = qkv + r0 * CONVCH + hh * HD; a.q_stride = CONVCH;
        a.K1 = F.in(3) + (((size_t)j * DB + bs) * PAST) * MIXW + hh * HD; a.V1 = F.in(4) + (((size_t)j * DB + bs) * PAST) * MIXW + hh * HD;
        a.K2 = out + O_SFK + ((size_t)j * MS + (size_t)bs * DS) * MIXW + hh * HD - (size_t)PAST * MIXW; a.V2 = out + O_SFV + ((size_t)j * MS + (size_t)bs * DS) * MIXW + hh * HD - (size_t)PAST * MIXW;
        a.kv_stride = MIXW; a.kvb16 = 0; a.jsw = PAST / 64; a.P0 = PAST; a.skv = FS_LEN; a.nvalid = DS;
        a.G = F.fs() + ((size_t)bs * NH + hh) * FS_LEN; a.gref = __hip_atomic_load(a.G + PAST, __ATOMIC_RELAXED, __HIP_MEMORY_SCOPE_AGENT);
        a.O = br + r0 * BRW + hh * HD;
    } else if (idx < n_fp + n_fs + n_mp) {
        const int s = idx - n_fp - n_fs, qb = s / (NB * NMH), bh = s % (NB * NMH), b = bh / NMH, hm = bh % NMH; const size_t r0 = (size_t)b * SEQ + (size_t)qb * 256;
        a.Q = qm + r0 * MEMW + hm * HD; a.q_stride = MEMW;
        a.K1 = out + O_PMK + ((size_t)L * 512 + (size_t)b * NMEM) * MEMW + hm * HD; a.V1 = out + O_PMV + ((size_t)L * 512 + (size_t)b * NMEM) * MEMW + hm * HD; a.K2 = a.K1; a.V2 = a.V1;
        a.kv_stride = MEMW; a.kvb16 = 0; a.jsw = 1 << 20; a.P0 = 1 << 20; a.skv = NMEM; a.nvalid = 256;
        a.G = (const float*)(F.ws() + WS_ZERO); a.gref = 0.f;
        a.O = br + r0 * BRW + MIXW + hm * HD;
    } else {
        const int s = idx - n_fp - n_fs - n_mp, bs = s / NMH, hm = s % NMH; const size_t r0 = (size_t)MP + (size_t)bs * DS;
        a.Q = qm + r0 * MEMW + hm * HD; a.q_stride = MEMW;
        a.K1 = F.in(8) + (((size_t)L * DB + bs) * NMEM) * MEMW + hm * HD; a.V1 = F.in(9) + (((size_t)L * DB + bs) * NMEM) * MEMW + hm * HD; a.K2 = a.K1; a.V2 = a.V1;
        a.kv_stride = MEMW; a.kvb16 = 0; a.jsw = 1 << 20; a.P0 = 1 << 20; a.skv = NMEM; a.nvalid = DS;
        a.G = (const float*)(F.ws() + WS_ZERO); a.gref = 0.f;
        a.O = br + r0 * BRW + MIXW + hm * HD;
    }
    return a;
}
template <bool B16>
__device__ __forceinline__ void attn_run_queue(Frame& F, int L, int qslot, int base, int count) {
    if (count <= 0) return;
    unsigned* qhead = F.ctl() + CW_Q + 64 * qslot;
    volatile LAS int* qs = (volatile LAS int*)(F.lds + att::OFF_Q);
    __syncthreads();
    if (F.tid == 0) { qs[0] = (int)atomicAdd(qhead, 1u); qs[1] = (int)atomicAdd(qhead, 1u); }
    __syncthreads();
    int i0 = qs[0], i1 = qs[1];
    if (i0 < count) {
        att::Ref cur = attn_item(F, L, base + i0);
        att::Seam S;
        att::attn_prime<B16>(cur, (LAS char*)F.lds, S, F.tid);
        for (;;) {
            const bool last = i1 >= count;
            if (F.tid == 0) qs[2] = (int)atomicAdd(qhead, 1u);
            att::Ref nref = cur; if (!last) nref = attn_item(F, L, base + i1);
            { const att::Next nxt = att::next_of(nref); att::attn_block<B16>(cur, nxt, (LAS char*)F.lds, S, F.tid); }
            if (last) break;
            const int i2 = qs[2];
            __syncthreads();
            cur = nref; i0 = i1; i1 = i2;
        }
        asm volatile("s_waitcnt vmcnt(0)" ::: "memory");
    }
    __syncthreads();
}
__device__ __forceinline__ void p_attention(Frame& F, int L, int qslot) {
    const int total = attn_total_items(L), n_fp = (L & 1) ? 0 : NB * NH * (SEQ / 256);
    if (!(L & 1)) attn_run_queue<true>(F, L, qslot + 8, 0, n_fp);
    attn_run_queue<false>(F, L, qslot, n_fp, total - n_fp);
}
namespace gdn {
constexpr int NU = 3072 + 384;
constexpr size_t T16 = 16384;
constexpr size_t G_KH = 0, G_QH = G_KH + NU * T16, G_KHT = G_QH + NU * T16, G_VT = G_KHT + NU * T16, G_QD = G_VT + NU * T16, G_KTT = G_QD + NU * T16;
constexpr size_t G_W = G_KTT + NU * T16, G_QK = G_W + NU * T16, G_U = G_QK + NU * 8192, G_GB = G_U + NU * 32768, G_O = G_GB + NU * 512, G_END = G_O + (size_t)MR * MIXW * 4;
static_assert(WS_GDN + G_END <= WS_END_MIN, "GDN workspace");

__device__ __forceinline__ unsigned cvtpk(float lo, float hi) { unsigned r; asm volatile("v_cvt_pk_bf16_f32 %0, %1, %2" : "=v"(r) : "v"(lo), "v"(hi)); return r; }
__device__ __forceinline__ int crow(int r, int hi) { return (r & 3) + 8 * (r >> 2) + 4 * hi; }

struct UnitInfo { int hh, nvalid, tabs; size_t row0; const float* hist; };
__device__ __forceinline__ UnitInfo unit_info(const Frame& F, int L, int u) {
    UnitInfo q; const int j = L >> 1;
    if (u < 3072) { const int b = u / 1536, n = u & 127; q.hh = (u >> 7) % NH; q.row0 = (size_t)b * SEQ + (size_t)n * 64; q.nvalid = 64; q.tabs = n * 64; q.hist = nullptr; }
    else { const int s = u - 3072, bs = s / NH; q.hh = s % NH; q.row0 = (size_t)MP + (size_t)bs * DS; q.nvalid = DS; q.tabs = 0; q.hist = F.in(7) + ((size_t)j * DB + bs) * 3 * CONVCH; }
    return q;
}

struct PreRegs { bf16x8 x[11]; };
__device__ __forceinline__ void pre_load(Frame& F, int L, int u, PreRegs& R) {
    const int j = L >> 1; const UnitInfo q = unit_info(F, L, u);
    const bf16_t* qkv = (const bf16_t*)F.qkv();
    int tid = F.tid; asm volatile("" : "+v"(tid));
    const int rg = tid / 48, cg = tid - rg * 48, sel = cg >> 4, d0 = (cg & 15) * 8, t0 = rg * 8, col = sel * MIXW + q.hh * HD + d0;
    if (tid < 384) {
        const char* ub = (const char*)qkv;
        int off0 = (int)(((long)q.row0 + t0 - 3) * CONVCH + col) * 2; asm volatile("" : "+v"(off0));
#pragma unroll
        for (int k = 0; k < 11; ++k) { const int rho = t0 - 3 + k;
            const bool valid = rho >= 0 ? rho < q.nvalid : (q.hist == nullptr && q.tabs + rho >= 0);
            const int off = valid ? off0 + k * (CONVCH * 2) : 0;
            bf16x8 v = *(const bf16x8*)(ub + (unsigned)off);
            if (!valid) v = bf16x8{};
            R.x[k] = v; }
        if (q.hist != nullptr && t0 == 0) {
#pragma unroll
            for (int k = 0; k < 3; ++k) { const float* hp = q.hist + (size_t)k * CONVCH + col; const f32x4 a = *(const f32x4*)hp, b = *(const f32x4*)(hp + 4);
                u32x4 pk; pk.x = pk2(a[0], a[1]); pk.y = pk2(a[2], a[3]); pk.z = pk2(b[0], b[1]); pk.w = pk2(b[2], b[3]); R.x[k] = __builtin_bit_cast(bf16x8, pk); } }
    }
}
__device__ __forceinline__ void pre_compute(Frame& F, int L, int u, const PreRegs& R) {
    const int j = L >> 1; const UnitInfo q = unit_info(F, L, u);
    LAS float* GRAW = (LAS float*)F.lds;
    LAS float* GT = GRAW + 64;
    LAS float* BT = GT + 64;
    unsigned char* gw = F.ws() + WS_GDN;
    int tid = F.tid; asm volatile("" : "+v"(tid));
    const int rg = tid / 48, cg = tid - rg * 48, sel = cg >> 4, d0 = (cg & 15) * 8, t0 = rg * 8, col = sel * MIXW + q.hh * HD + d0;
    const bool act = tid < 384;
    f32x4 w[4][2];
    if (act) { const float* cw = F.in(16) + (size_t)j * CONVW * CONVCH + col;
#pragma unroll
        for (int jj = 0; jj < 4; ++jj) { w[jj][0] = *(const f32x4*)(cw + (size_t)jj * CONVCH); w[jj][1] = *(const f32x4*)(cw + (size_t)jj * CONVCH + 4); } }
    __syncthreads();
    if (tid >= 384 && tid < 448) { const int t = tid - 384; const bool ok = t < q.nvalid;
        float run = ok ? F.ga()[(q.row0 + t) * NH + q.hh] : 0.f; const float bb = ok ? F.beta()[(q.row0 + t) * NH + q.hh] : 0.f;
#pragma unroll
        for (int o = 1; o < 64; o <<= 1) { const float up = __int_as_float(__builtin_amdgcn_ds_bpermute(((t - o) & 63) << 2, __float_as_int(run))); if (t >= o) run += up; }
        GT[t] = run; BT[t] = bb; float* gb = (float*)(gw + G_GB + (size_t)u * 512); gb[t] = run; gb[64 + t] = bb; }
    __syncthreads();
    if (act) {
        float y[8][8];
#pragma unroll
        for (int i = 0; i < 8; ++i)
#pragma unroll
            for (int e = 0; e < 8; ++e) y[i][e] = 0.f;
#pragma unroll
        for (int k = 0; k < 11; ++k) {
            float xf[8];
#pragma unroll
            for (int e = 0; e < 8; ++e) xf[e] = __uint_as_float((unsigned)(unsigned short)R.x[k][e] << 16);
#pragma unroll
            for (int jj = 0; jj < 4; ++jj) { const int i = k - jj; if (i >= 0 && i < 8) {
#pragma unroll
                for (int e = 0; e < 8; ++e) y[i][e] += w[jj][e >> 2][e & 3] * xf[e]; } }
        }
#pragma unroll
        for (int i = 0; i < 8; ++i)
#pragma unroll
            for (int e = 0; e < 8; ++e) y[i][e] = (t0 + i) < q.nvalid ? siluf(y[i][e]) : 0.f;
        if (sel < 2) {
#pragma unroll
            for (int i = 0; i < 8; ++i) { float ss = 0.f;
#pragma unroll
                for (int e = 0; e < 8; ++e) ss += y[i][e] * y[i][e];
                ss += shfl_xor_l(ss, 1, F.lane); ss += shfl_xor_l(ss, 2, F.lane); ss += shfl_xor_l(ss, 4, F.lane); ss += shfl_xor_l(ss, 8, F.lane);
                const float rn = (1.f / sqrtf(ss + EPS)) * (sel == 0 ? ATT_SCALE : 1.f);
#pragma unroll
                for (int e = 0; e < 8; ++e) y[i][e] *= rn; }
        }
        const float glast = GT[63];
#define ROW8(i_, s_) ({ u32x4 p_; p_.x = cvtpk(y[i_][0] * (s_), y[i_][1] * (s_)); p_.y = cvtpk(y[i_][2] * (s_), y[i_][3] * (s_)); p_.z = cvtpk(y[i_][4] * (s_), y[i_][5] * (s_)); p_.w = cvtpk(y[i_][6] * (s_), y[i_][7] * (s_)); p_; })
        if (sel == 0) {
            const unsigned lo_ = (unsigned)(t0 * 128 + d0) * 2u; bf16_t* QH = (bf16_t*)(gw + G_QH + (size_t)u * T16 + lo_); bf16_t* QD = (bf16_t*)(gw + G_QD + (size_t)u * T16 + lo_);
#pragma unroll
            for (int i = 0; i < 8; ++i) { *(u32x4*)(QH + i * 128) = ROW8(i, 1.f); const float eg = __expf(GT[t0 + i]); *(u32x4*)(QD + i * 128) = ROW8(i, eg); }
        } else if (sel == 1) {
            const unsigned lo_ = (unsigned)(t0 * 128 + d0) * 2u, lt_ = (unsigned)(d0 * 64 + t0) * 2u; bf16_t* KH = (bf16_t*)(gw + G_KH + (size_t)u * T16 + lo_); bf16_t* KHT = (bf16_t*)(gw + G_KHT + (size_t)u * T16 + lt_); bf16_t* KTT = (bf16_t*)(gw + G_KTT + (size_t)u * T16 + lt_);
            float ek[8];
#pragma unroll
            for (int i = 0; i < 8; ++i) { *(u32x4*)(KH + i * 128) = ROW8(i, 1.f); ek[i] = __expf(glast - GT[t0 + i]); }
#pragma unroll
            for (int e = 0; e < 8; ++e) { u32x4 c0, c1;
                c0.x = cvtpk(y[0][e], y[1][e]); c0.y = cvtpk(y[2][e], y[3][e]); c0.z = cvtpk(y[4][e], y[5][e]); c0.w = cvtpk(y[6][e], y[7][e]);
                c1.x = cvtpk(y[0][e] * ek[0], y[1][e] * ek[1]); c1.y = cvtpk(y[2][e] * ek[2], y[3][e] * ek[3]); c1.z = cvtpk(y[4][e] * ek[4], y[5][e] * ek[5]); c1.w = cvtpk(y[6][e] * ek[6], y[7][e] * ek[7]);
                *(u32x4*)(KHT + e * 64) = c0; *(u32x4*)(KTT + e * 64) = c1; }
        } else {
            const unsigned lt_ = (unsigned)(d0 * 64 + t0) * 2u; bf16_t* VT = (bf16_t*)(gw + G_VT + (size_t)u * T16 + lt_);
#pragma unroll
            for (int e = 0; e < 8; ++e) { u32x4 c0; c0.x = cvtpk(y[0][e], y[1][e]); c0.y = cvtpk(y[2][e], y[3][e]); c0.z = cvtpk(y[4][e], y[5][e]); c0.w = cvtpk(y[6][e], y[7][e]); *(u32x4*)(VT + e * 64) = c0; }
        }
#undef ROW8
    }
}
__device__ __forceinline__ void p_gdn_pre(Frame& F, int L) {
    int u = F.bid; if (u >= NU) return;
    PreRegs A, B; pre_load(F, L, u, A);
#pragma unroll 1
    for (;;) {
        { const int un = u + F.G; const bool more = un < NU; pre_load(F, L, more ? un : u, B); pre_compute(F, L, u, A); if (!more) break; u = un; }
        { const int un = u + F.G; const bool more = un < NU; pre_load(F, L, more ? un : u, A); pre_compute(F, L, u, B); if (!more) break; u = un; }
    }
}

constexpr int TP = 72;
constexpr int PW = 64 * TP * 2 + 512;
__device__ __forceinline__ void solve_unit(Frame& F, int u) {
    unsigned char* gw = F.ws() + WS_GDN;
    const int lane = F.lane, r32 = lane & 31, hi = lane >> 5;
    LAS bf16_t* Tl = (LAS bf16_t*)(F.lds + F.wave * PW); LAS float* gt = (LAS float*)(F.lds + F.wave * PW + 64 * TP * 2); LAS float* bt = gt + 64;
    const float* gb = (const float*)(gw + G_GB + (size_t)u * 512);
    const float Gl = gb[lane], Bl = gb[64 + lane];
    gt[lane] = Gl; bt[lane] = Bl;
    const bf16_t* KH = (const bf16_t*)(gw + G_KH + (size_t)u * T16); const bf16_t* QH = (const bf16_t*)(gw + G_QH + (size_t)u * T16);
    const bf16_t* KHT = (const bf16_t*)(gw + G_KHT + (size_t)u * T16); const bf16_t* VT = (const bf16_t*)(gw + G_VT + (size_t)u * T16);
    bf16_t* Wg = (bf16_t*)(gw + G_W + (size_t)u * T16); bf16_t* QKg = (bf16_t*)(gw + G_QK + (size_t)u * 8192); f32x4* Ug = (f32x4*)(gw + G_U + (size_t)u * 32768);
    bf16x8 kf[2][8];
#pragma unroll
    for (int mt = 0; mt < 2; ++mt)
#pragma unroll
        for (int ks = 0; ks < 8; ++ks) kf[mt][ks] = *(const bf16x8*)(KH + (32 * mt + r32) * 128 + 16 * ks + 8 * hi);
    {
        bf16x8 qf[2][8];
#pragma unroll
        for (int nt = 0; nt < 2; ++nt)
#pragma unroll
            for (int ks = 0; ks < 8; ++ks) qf[nt][ks] = *(const bf16x8*)(QH + (32 * nt + r32) * 128 + 16 * ks + 8 * hi);
#pragma unroll
        for (int nt = 0; nt < 2; ++nt)
#pragma unroll
            for (int mt = 0; mt < 2; ++mt) {
                const int i = 32 * nt + r32; u32x2 w[4];
                if (mt <= nt) {
                    f32x16 acc = {};
#pragma unroll
                    for (int ks = 0; ks < 8; ++ks) acc = __builtin_amdgcn_mfma_f32_32x32x16_bf16(kf[mt][ks], qf[nt][ks], acc, 0, 0, 0);
                    const float Gi = gt[i];
#pragma unroll
                    for (int g = 0; g < 4; ++g) { const int j0 = 32 * mt + 8 * g + 4 * hi; const f32x4 gj = *(const LAS f32x4*)(gt + j0); float v[4];
#pragma unroll
                        for (int e = 0; e < 4; ++e) v[e] = (i >= j0 + e) ? acc[4 * g + e] * __expf(Gi - gj[e]) : 0.f;
                        w[g].x = cvtpk(v[0], v[1]); w[g].y = cvtpk(v[2], v[3]); }
                } else {
#pragma unroll
                    for (int g = 0; g < 4; ++g) { w[g].x = 0u; w[g].y = 0u; }
                }
#pragma unroll
                for (int g = 0; g < 4; ++g) *(u32x2*)(QKg + i * 64 + 32 * mt + 8 * g + 4 * hi) = w[g];
            }
    }
    float Arow[64];
    {
        f32x16 k00 = {}, k10 = {}, k11 = {};
#pragma unroll
        for (int ks = 0; ks < 8; ++ks) { k00 = __builtin_amdgcn_mfma_f32_32x32x16_bf16(kf[0][ks], kf[0][ks], k00, 0, 0, 0);
            k10 = __builtin_amdgcn_mfma_f32_32x32x16_bf16(kf[1][ks], kf[0][ks], k10, 0, 0, 0); k11 = __builtin_amdgcn_mfma_f32_32x32x16_bf16(kf[1][ks], kf[1][ks], k11, 0, 0, 0); }
#pragma unroll
        for (int r = 0; r < 16; ++r) {
            { auto rr = __builtin_amdgcn_permlane32_swap(__float_as_uint(k00[r]), 0u, false, false);
              Arow[crow(r, 0)] = __uint_as_float(rr[0]); Arow[crow(r, 1)] = __uint_as_float(rr[1]); }
            { auto rr = __builtin_amdgcn_permlane32_swap(__float_as_uint(k10[r]), __float_as_uint(k11[r]), false, false);
              Arow[32 + crow(r, 0)] = __uint_as_float(rr[0]); Arow[32 + crow(r, 1)] = __uint_as_float(rr[1]); }
        }
#pragma unroll
        for (int i = 0; i < 64; ++i) { const float gi = gt[i], bi = bt[i]; Arow[i] = (lane < i) ? bi * Arow[i] * __expf(gi - Gl) : 0.f; }
    }
    float x[64];
#pragma unroll
    for (int i = 0; i < 64; ++i) {
        float ac0 = (lane == i) ? 1.f : 0.f, ac1 = 0.f, ac2 = 0.f, ac3 = 0.f;
#pragma unroll
        for (int jj = 0; jj < i; ++jj) { const float a = __uint_as_float(__builtin_amdgcn_readlane(__float_as_uint(Arow[i]), jj));
            if ((jj & 3) == 0) ac0 -= a * x[jj]; else if ((jj & 3) == 1) ac1 -= a * x[jj]; else if ((jj & 3) == 2) ac2 -= a * x[jj]; else ac3 -= a * x[jj]; }
        x[i] = (ac0 + ac1) + (ac2 + ac3);
    }
#pragma unroll
    for (int i = 0; i < 64; ++i) Tl[i * TP + lane] = f2bf(x[i] * Bl);
#pragma unroll 1
    for (int nt = 0; nt < 4; ++nt) {
        f32x16 a0 = {}, a1 = {};
#pragma unroll
        for (int ks = 0; ks < 4; ++ks) { const bf16x8 bfr = *(const bf16x8*)(VT + (32 * nt + r32) * 64 + 16 * ks + 8 * hi);
            a0 = __builtin_amdgcn_mfma_f32_32x32x16_bf16(*(const LAS bf16x8*)(Tl + r32 * TP + 16 * ks + 8 * hi), bfr, a0, 0, 0, 0);
            a1 = __builtin_amdgcn_mfma_f32_32x32x16_bf16(*(const LAS bf16x8*)(Tl + (32 + r32) * TP + 16 * ks + 8 * hi), bfr, a1, 0, 0, 0); }
#pragma unroll
        for (int qd = 0; qd < 4; ++qd) { Ug[((nt * 2 + 0) * 4 + qd) * 64 + lane] = (f32x4){a0[4 * qd], a0[4 * qd + 1], a0[4 * qd + 2], a0[4 * qd + 3]};
            Ug[((nt * 2 + 1) * 4 + qd) * 64 + lane] = (f32x4){a1[4 * qd], a1[4 * qd + 1], a1[4 * qd + 2], a1[4 * qd + 3]}; }
    }
    { const float be = Bl * __expf(Gl);
#pragma unroll
      for (int i = 0; i < 64; ++i) Tl[i * TP + lane] = f2bf(x[i] * be); }
#pragma unroll 1
    for (int mt = 0; mt < 4; ++mt) {
        f32x16 a0 = {}, a1 = {};
#pragma unroll
        for (int ks = 0; ks < 4; ++ks) { const bf16x8 afr = *(const bf16x8*)(KHT + (32 * mt + r32) * 64 + 16 * ks + 8 * hi);
            a0 = __builtin_amdgcn_mfma_f32_32x32x16_bf16(afr, *(const LAS bf16x8*)(Tl + r32 * TP + 16 * ks + 8 * hi), a0, 0, 0, 0);
            a1 = __builtin_amdgcn_mfma_f32_32x32x16_bf16(afr, *(const LAS bf16x8*)(Tl + (32 + r32) * TP + 16 * ks + 8 * hi), a1, 0, 0, 0); }
#pragma unroll
        for (int g = 0; g < 4; ++g) { u32x2 w0, w1; w0.x = cvtpk(-a0[4 * g], -a0[4 * g + 1]); w0.y = cvtpk(-a0[4 * g + 2], -a0[4 * g + 3]); w1.x = cvtpk(-a1[4 * g], -a1[4 * g + 1]); w1.y = cvtpk(-a1[4 * g + 2], -a1[4 * g + 3]);
            *(u32x2*)(Wg + r32 * 128 + 32 * mt + 8 * g + 4 * hi) = w0; *(u32x2*)(Wg + (32 + r32) * 128 + 32 * mt + 8 * g + 4 * hi) = w1; }
    }
}
__device__ __forceinline__ void p_gdn_solve(Frame& F) {
    const int gwv = F.bid * NWAVES + F.wave, NGW = F.G * NWAVES;
#pragma unroll 1
    for (int u = gwv; u < NU; u += NGW) solve_unit(F, u);
}

constexpr int P128 = 132, P64 = 68;
constexpr int SB_W = 0, SB_QD = SB_W + 64 * P128 * 2, SB_QK = SB_QD + 64 * P128 * 2, SB_KTT = SB_QK + 64 * P64 * 2, SB_BYTES = SB_KTT + 128 * P64 * 2;
static_assert(2 * SB_BYTES <= 131072, "scan LDS");
__device__ __forceinline__ bf16x8 cvt8(const f32x16& a, int s) {
    u32x4 w; w.x = cvtpk(a[8 * s], a[8 * s + 1]); w.y = cvtpk(a[8 * s + 2], a[8 * s + 3]); w.z = cvtpk(a[8 * s + 4], a[8 * s + 5]); w.w = cvtpk(a[8 * s + 6], a[8 * s + 7]); return __builtin_bit_cast(bf16x8, w);
}
__device__ __forceinline__ bf16x8 afrag(const LAS bf16_t* base, int pitch, int row, int k0, int hi) {
    const LAS bf16_t* p = base + row * pitch + k0 + 4 * hi;
    const u32x2 lo = *(const LAS u32x2*)p, hi2 = *(const LAS u32x2*)(p + 8);
    u32x4 w = {lo.x, lo.y, hi2.x, hi2.y}; return __builtin_bit_cast(bf16x8, w);
}
template <int CW>
__device__ __forceinline__ void scan_seq(Frame& F, int L, int s, int part) {
    const int j = L >> 1; const int tid = F.tid, lane = F.lane, r32 = lane & 31, hi = lane >> 5, wv = F.wave;
    unsigned char* gw = F.ws() + WS_GDN;
    int u0, nchunk, nvalid, hh; size_t row0; const float* S0; float* Sout;
    if (s < NB * NH) { const int b = s / NH; hh = s % NH; u0 = s * 128; nchunk = 128; nvalid = 64; row0 = (size_t)b * SEQ; S0 = nullptr; Sout = F.out() + O_PGS + (((size_t)j * NB + b) * NH + hh) * HD * HD; }
    else { const int q = s - NB * NH, bs = q / NH; hh = q % NH; u0 = 3072 + q; nchunk = 1; nvalid = DS; row0 = (size_t)MP + (size_t)bs * DS;
        S0 = F.in(6) + (((size_t)j * DB + bs) * NH + hh) * HD * HD; Sout = F.out() + O_SGS + (((size_t)j * DB + bs) * NH + hh) * HD * HD; }
    float* Og = (float*)(gw + G_O);
    __syncthreads();
    if (wv >= 4) {
        const int t2 = tid - 256;
        u32x4 sa[14], sb[14];
#define LW16(p_, v_) do { LAS u32x2* q_ = (LAS u32x2*)(p_); q_[0] = (u32x2){(v_).x, (v_).y}; q_[1] = (u32x2){(v_).z, (v_).w}; } while (0)
#define ST_LOAD(st, u_) do { const unsigned char* bw = gw + G_W + (size_t)(u_) * T16; const unsigned char* bq = gw + G_QD + (size_t)(u_) * T16; \
            const unsigned char* bk = gw + G_QK + (size_t)(u_) * 8192; const unsigned char* bt_ = gw + G_KTT + (size_t)(u_) * T16; \
            unsigned lo_ = (unsigned)t2 * 16u; asm volatile("" : "+v"(lo_)); \
            _Pragma("unroll") for (int k = 0; k < 4; ++k) { st[k] = *(const u32x4*)(bw + 4096 * k + lo_); st[4 + k] = *(const u32x4*)(bq + 4096 * k + lo_); st[10 + k] = *(const u32x4*)(bt_ + 4096 * k + lo_); } \
            st[8] = *(const u32x4*)(bk + lo_); st[9] = *(const u32x4*)(bk + 4096 + lo_); } while (0)
#define ST_WRITE(st, buf_) do { LAS unsigned char* B_ = F.lds + (buf_) * SB_BYTES; \
            _Pragma("unroll") for (int k = 0; k < 4; ++k) { LW16(B_ + SB_W + (((t2 >> 4) + 16 * k) * P128 + (t2 & 15) * 8) * 2, st[k]); LW16(B_ + SB_QD + (((t2 >> 4) + 16 * k) * P128 + (t2 & 15) * 8) * 2, st[4 + k]); \
                LW16(B_ + SB_KTT + (((t2 >> 3) + 32 * k) * P64 + (t2 & 7) * 8) * 2, st[10 + k]); } \
            LW16(B_ + SB_QK + ((t2 >> 3) * P64 + (t2 & 7) * 8) * 2, st[8]); LW16(B_ + SB_QK + (((t2 >> 3) + 32) * P64 + (t2 & 7) * 8) * 2, st[9]); } while (0)
#define UCL(k_) (u0 + ((k_) < nchunk ? (k_) : nchunk - 1))
        ST_LOAD(sa, u0); ST_WRITE(sa, 0); ST_LOAD(sb, UCL(1));
        __syncthreads();
#pragma unroll 1
        for (int n = 0;;) {
            ST_LOAD(sa, UCL(n + 2)); ST_WRITE(sb, (n + 1) & 1);
            asm volatile("s_waitcnt lgkmcnt(0)\n\ts_barrier" ::: "memory"); if (++n >= nchunk) break;
            ST_LOAD(sb, UCL(n + 2)); ST_WRITE(sa, (n + 1) & 1);
            asm volatile("s_waitcnt lgkmcnt(0)\n\ts_barrier" ::: "memory"); if (++n >= nchunk) break;
        }
#undef UCL
#undef ST_LOAD
#undef ST_WRITE
#undef LW16
    } else if (wv >= CW) {
        __syncthreads();
#pragma unroll 1
        for (int n = 0; n < nchunk; ++n) asm volatile("s_waitcnt lgkmcnt(0)\n\ts_barrier" ::: "memory");
    } else {
        const int cs = part * CW + wv;
        f32x16 S[4];
#pragma unroll
        for (int t = 0; t < 4; ++t)
#pragma unroll
            for (int r = 0; r < 16; ++r) S[t][r] = S0 ? S0[(size_t)(32 * t + crow(r, hi)) * HD + 32 * cs + r32] : 0.f;
        f32x16 U0, U1;
#define U_LOAD(u_) do { const unsigned char* Ub = gw + G_U + (size_t)(u_) * 32768 + (size_t)cs * 8192; unsigned ul_ = (unsigned)lane * 16u; asm volatile("" : "+v"(ul_)); \
            _Pragma("unroll") for (int qd = 0; qd < 4; ++qd) { const f32x4 a = *(const f32x4*)(Ub + qd * 1024 + ul_), b = *(const f32x4*)(Ub + 4096 + qd * 1024 + ul_); \
                U0[4 * qd] = a[0]; U0[4 * qd + 1] = a[1]; U0[4 * qd + 2] = a[2]; U0[4 * qd + 3] = a[3]; U1[4 * qd] = b[0]; U1[4 * qd + 1] = b[1]; U1[4 * qd + 2] = b[2]; U1[4 * qd + 3] = b[3]; } } while (0)
        U_LOAD(u0);
        float glraw = ((const float*)(gw + G_GB + (size_t)u0 * 512))[63];
        __syncthreads();
#pragma unroll 1
        for (int n = 0; n < nchunk; ++n) {
            const int u = u0 + n; const bool more = n + 1 < nchunk;
            const LAS unsigned char* B_ = F.lds + (n & 1) * SB_BYTES;
            const LAS bf16_t* Wl = (const LAS bf16_t*)(B_ + SB_W); const LAS bf16_t* QDl = (const LAS bf16_t*)(B_ + SB_QD);
            const LAS bf16_t* QKl = (const LAS bf16_t*)(B_ + SB_QK); const LAS bf16_t* KTl = (const LAS bf16_t*)(B_ + SB_KTT);
            const float gl = __expf(glraw);
            glraw = ((const float*)(gw + G_GB + (size_t)(more ? u + 1 : u) * 512))[63];
            f32x16 o0 = {}, o1 = {}, vn0 = {}, vn1 = {};
            bf16x8 fp[3][4];
#define LOADG(dst, g_) do { const int k0 = 16 * (g_); dst[0] = afrag(Wl, P128, r32, k0, hi); dst[1] = afrag(Wl, P128, 32 + r32, k0, hi); dst[2] = afrag(QDl, P128, r32, k0, hi); dst[3] = afrag(QDl, P128, 32 + r32, k0, hi); } while (0)
            LOADG(fp[0], 0); LOADG(fp[1], 1);
#pragma unroll
            for (int gq = 0; gq < 8; ++gq) {
                const bf16x8 bfr = cvt8(S[gq >> 1], gq & 1);
                vn0 = __builtin_amdgcn_mfma_f32_32x32x16_bf16(fp[gq % 3][0], bfr, vn0, 0, 0, 0); vn1 = __builtin_amdgcn_mfma_f32_32x32x16_bf16(fp[gq % 3][1], bfr, vn1, 0, 0, 0);
                o0 = __builtin_amdgcn_mfma_f32_32x32x16_bf16(fp[gq % 3][2], bfr, o0, 0, 0, 0); o1 = __builtin_amdgcn_mfma_f32_32x32x16_bf16(fp[gq % 3][3], bfr, o1, 0, 0, 0);
                __builtin_amdgcn_sched_barrier(0);
                if (gq + 2 < 8) LOADG(fp[(gq + 2) % 3], gq + 2);
            }
#undef LOADG
            bf16x8 fa[2][8];
            __builtin_amdgcn_sched_barrier(0);
#pragma unroll
            for (int t = 0; t < 4; ++t)
#pragma unroll
                for (int r = 0; r < 16; ++r) S[t][r] *= gl;
#pragma unroll
            for (int r = 0; r < 16; ++r) { vn0[r] += U0[r]; vn1[r] += U1[r]; }
            bf16x8 vb[4]; vb[0] = cvt8(vn0, 0); vb[1] = cvt8(vn0, 1); vb[2] = cvt8(vn1, 0); vb[3] = cvt8(vn1, 1);
            __builtin_amdgcn_sched_barrier(0);
            U_LOAD(more ? u + 1 : u);
#pragma unroll
            for (int c = 0; c < 4; ++c) { fa[0][2 * c] = afrag(QKl, P64, r32, 16 * c, hi); fa[0][2 * c + 1] = afrag(QKl, P64, 32 + r32, 16 * c, hi); }
#pragma unroll
            for (int c = 0; c < 4; ++c) { fa[1][c] = afrag(KTl, P64, r32, 16 * c, hi); fa[1][4 + c] = afrag(KTl, P64, 32 + r32, 16 * c, hi); }
#pragma unroll
            for (int c = 0; c < 4; ++c) { o0 = __builtin_amdgcn_mfma_f32_32x32x16_bf16(fa[0][2 * c], vb[c], o0, 0, 0, 0); o1 = __builtin_amdgcn_mfma_f32_32x32x16_bf16(fa[0][2 * c + 1], vb[c], o1, 0, 0, 0); }
#pragma unroll
            for (int c = 0; c < 4; ++c) S[0] = __builtin_amdgcn_mfma_f32_32x32x16_bf16(fa[1][c], vb[c], S[0], 0, 0, 0);
            __builtin_amdgcn_sched_barrier(0);
#pragma unroll
            for (int c = 0; c < 4; ++c) { fa[0][c] = afrag(KTl, P64, 64 + r32, 16 * c, hi); fa[0][4 + c] = afrag(KTl, P64, 96 + r32, 16 * c, hi); }
            __builtin_amdgcn_sched_barrier(0);
#pragma unroll
            for (int c = 0; c < 4; ++c) S[1] = __builtin_amdgcn_mfma_f32_32x32x16_bf16(fa[1][4 + c], vb[c], S[1], 0, 0, 0);
#pragma unroll
            for (int c = 0; c < 4; ++c) { S[2] = __builtin_amdgcn_mfma_f32_32x32x16_bf16(fa[0][c], vb[c], S[2], 0, 0, 0); S[3] = __builtin_amdgcn_mfma_f32_32x32x16_bf16(fa[0][4 + c], vb[c], S[3], 0, 0, 0); }
            unsigned char* ob = (unsigned char*)(Og + (row0 + (size_t)n * 64) * MIXW + hh * HD + 32 * cs);
            unsigned ol_ = ((unsigned)(4 * hi) * MIXW + (unsigned)r32) * 4u; asm volatile("" : "+v"(ol_));
#pragma unroll
            for (int r = 0; r < 16; ++r) { const int i0 = (r & 3) + 8 * (r >> 2);
                if (i0 + 4 * hi < nvalid) *(float*)(ob + (size_t)i0 * MIXW * 4 + ol_) = o0[r];
                if (32 + i0 + 4 * hi < nvalid) *(float*)(ob + (size_t)(32 + i0) * MIXW * 4 + ol_) = o1[r]; }
            asm volatile("s_waitcnt lgkmcnt(0)\n\ts_barrier" ::: "memory");
        }
#undef U_LOAD
#pragma unroll
        for (int t = 0; t < 4; ++t)
#pragma unroll
            for (int r = 0; r < 16; ++r) Sout[(size_t)(32 * t + crow(r, hi)) * HD + 32 * cs + r32] = S[t][r];
    }
}
__device__ __forceinline__ void p_gdn_scan(Frame& F, int L) {
    constexpr int NPW = NB * NH * 4;
    if (F.bid < NPW) { const int w = F.bid; scan_seq<1>(F, L, (w & 7) + 8 * (w >> 5), (w >> 3) & 3); }
    else { const int nw = F.G - NPW;
#pragma unroll 1
        for (int q = F.bid - NPW; q < DB * NH; q += nw) scan_seq<4>(F, L, NB * NH + q, 0);
        if (L == 1) convert_weights(F, 2, 4, F.bid - NPW, nw); }
}
__device__ __forceinline__ void p_gdn_post(Frame& F, int L) {
    const int j = L >> 1; const int gwv = F.bid * NWAVES + F.wave, NGW = F.G * NWAVES;
    const float* Og = (const float*)(F.ws() + WS_GDN + G_O); const bf16_t* zs = (const bf16_t*)F.zs(); bf16_t* br = (bf16_t*)F.br();
    const f32x2 gn = *(const f32x2*)(F.in(19) + (size_t)j * HD + 2 * F.lane);
#pragma unroll 1
    for (int it0 = gwv; it0 < MR * NH; it0 += 4 * NGW) {
        f32x2 o[4]; unsigned zz[4]; size_t off[4];
#pragma unroll
        for (int k = 0; k < 4; ++k) { int it = it0 + k * NGW; if (it >= MR * NH) it = it0; const int row = it / NH, hh = it % NH; off[k] = (size_t)row * BRW + hh * HD + 2 * F.lane;
            o[k] = *(const f32x2*)(Og + (size_t)row * MIXW + hh * HD + 2 * F.lane); zz[k] = *(const unsigned*)(zs + off[k]); }
#pragma unroll
        for (int k = 0; k < 4; ++k) { const float rstd = 1.f / sqrtf(wave_sum(o[k].x * o[k].x + o[k].y * o[k].y, F.lane) * (1.f / HD) + EPS);
            if (it0 + k * NGW < MR * NH) *(unsigned*)(br + off[k]) = pk2(o[k].x * rstd * gn.x * __uint_as_float(zz[k] << 16), o[k].y * rstd * gn.y * __uint_as_float(zz[k] & 0xffff0000u)); }
    }
}
}
constexpr int LDS_BYTES = 147456;
constexpr int MISC_OFF = 131072 + 320;
constexpr int NPH = 31;
#ifndef N_LAUNCHES
#define N_LAUNCHES 1
#endif

struct Args { const float* in[22]; float* out; unsigned char* ws; int ph_lo, ph_hi; };

__global__ void __launch_bounds__(NT, 2) fwd(Args args) {
    extern __shared__ __attribute__((aligned(16))) unsigned char lds_raw[];
    Frame F;
    F.lds = (LAS unsigned char*)lds_raw;
    F.tid = threadIdx.x; F.lane = F.tid & 63; F.wave = __builtin_amdgcn_readfirstlane(F.tid >> 6);
    F.G = gridDim.x; F.bid = blockIdx.x;
    volatile LAS unsigned* MISC = (volatile LAS unsigned*)(F.lds + MISC_OFF);
    if (F.tid < 32) MISC[F.tid] = 0u;
    if (F.tid < 24) { const unsigned long long v = F.tid < 22 ? (unsigned long long)args.in[F.tid] : (F.tid == 22 ? (unsigned long long)args.out : (unsigned long long)args.ws);
        ((LAS unsigned long long*)(F.lds + PTR_OFF))[F.tid] = v; }
    __syncthreads();
    XcdBarrier bar; bar.bar = F.ctl() + CW_BAR; bar.x = 0; bar.st = nullptr;
    const bool multi = (args.ph_hi - args.ph_lo) > 1;
    if (multi) bar = xcd_barrier_post(F.ctl() + CW_BAR, MISC + 8, F.tid);
    const int lo = args.ph_lo, hi = args.ph_hi;
#define IN(k) (lo <= (k) && (k) < hi)
#define PHASE_FRAME() F.tid = F.wave * 64 + (int)__builtin_amdgcn_mbcnt_hi(~0u, __builtin_amdgcn_mbcnt_lo(~0u, 0u)); asm volatile("" : "+v"(F.tid)); asm volatile("" : "+s"(F.bid), "+s"(F.G)); { unsigned l_ = (unsigned)(size_t)F.lds; asm volatile("" : "+s"(l_)); F.lds = (LAS unsigned char*)(size_t)l_; } F.lane = F.tid & 63
#define SEAM(k) do { if (IN(k) && ((k) + 1 < hi)) { xcd_barrier(bar, F.wave * 64 + (int)__builtin_amdgcn_mbcnt_hi(~0u, __builtin_amdgcn_mbcnt_lo(~0u, 0u))); } } while (0)

    { if (IN(0)) { PHASE_FRAME(); p_prologue(F); p_norm(F, 0); } } SEAM(0);
#ifndef PROBE_KIND
#define PROBE_KIND -1
#endif
#define REPS(kind_) ((PROBE_KIND) == (kind_) ? 2 : 1)
#define PDUP(kind_, ...) { constexpr int qrep_ = 0; __VA_ARGS__ } if ((PROBE_KIND) == (kind_)) { XBAR(); { constexpr int qrep_ = 1; __VA_ARGS__ } }
#define QSLOT(L) ((L) + 4 * qrep_)
#define XBAR() xcd_barrier(bar, F.wave * 64 + (int)__builtin_amdgcn_mbcnt_hi(~0u, __builtin_amdgcn_mbcnt_lo(~0u, 0u)))
#define LAYER_BODY(L) { constexpr int pb = 2 + 7 * (L); constexpr bool GDN = ((L) & 1) != 0; \
        if ((L) != 0) { PDUP(-2, if (IN(pb)) { PHASE_FRAME(); p_norm(F, L); }) SEAM(pb); } \
        PDUP(3 + 4 * ((L) & 1) + 100 * ((L) >> 1), if (IN(pb + 1)) { PHASE_FRAME(); \
            pg8::Gemm g{F.h(), F.wt_in(L), MR, NIN, DM}; pg8::StaticOrder S; S.init(MR, NIN, F.G, F.bid); const EpiInProjV E = mk_epi_inproj_v(F, L); \
            pg8::gemm_phase<EpiInProjV, pg8::StaticOrder, true, true>(F.lds, g, S, E, F.tid); \
            if ((L) == 0) { __syncthreads();   \
                pg8::Gemm g2{F.hm(0), F.wt_mkv(0), 2048, 4096, DM}; MemKvOrder S2{F.G, F.G >= 32 ? F.bid - (F.G - 32) : F.bid}; EpiMemKVV E2{F.out()}; pg8::gemm_phase<EpiMemKVV, MemKvOrder, true, true>(F.lds, g2, S2, E2, F.tid); } }) SEAM(pb + 1); \
        PDUP((GDN ? 8 : 4) + 100 * ((L) >> 1), if (IN(pb + 2)) { PHASE_FRAME(); \
            if (GDN) GDN_PRE(F, L); else p_cumsum(F, L); }) SEAM(pb + 2); \
        if (GDN) { PDUP(9 + 100 * ((L) >> 1), if (IN(pb + 3)) { PHASE_FRAME(); GDN_SOLVE(F); }) SEAM(pb + 3); } \
        PDUP((GDN ? 10 : 5) + 100 * ((L) >> 1), if (IN(pb + 4)) { PHASE_FRAME(); if (GDN) GDN_SCAN(F, L); p_attention(F, L, QSLOT(L)); }) SEAM(pb + 4); \
        if (GDN) { PDUP(11 + 100 * ((L) >> 1), if (IN(pb + 5)) { PHASE_FRAME(); GDN_POST(F, L); }) SEAM(pb + 5); } \
        PDUP((L) == 0 ? 6 : -2, if (IN(pb + 6)) { PHASE_FRAME(); \
            pg8::Gemm g{(const bf16_t*)F.br(), F.wt_out(L), MR, DM, BRW}; OutProjOrder S; S.init(F.G, F.bid); EpiOutProjV E{L, F.out(), F.in(0), F.in(1), (float*)(F.ws() + WS_PART)}; \
            pg8::gemm_phase<EpiOutProjV, OutProjOrder, true, true>(F.lds, g, S, E, F.tid); }) SEAM(pb + 6); }
#if USE_GDN_CHUNK
#define GDN_PRE(F, L) gdn::p_gdn_pre(F, L)
#define GDN_SOLVE(F) gdn::p_gdn_solve(F)
#define GDN_SCAN(F, L) gdn::p_gdn_scan(F, L)
#define GDN_POST(F, L) gdn::p_gdn_post(F, L)
#else
#define GDN_PRE(F, L) do {} while (0)
#define GDN_SOLVE(F) do {} while (0)
#define GDN_SCAN(F, L) p_gdn_naive(F, L)
#define GDN_POST(F, L) do {} while (0)
#endif
    LAYER_BODY(0)
    LAYER_BODY(1)
    LAYER_BODY(2)
    LAYER_BODY(3)
    { if (IN(30)) { PHASE_FRAME(); p_final_norm(F); } }
#undef IN
#undef SEAM
}

extern "C" void kernel_launch(void* const* d_in, const int* in_sizes, int n_in, void* d_out, int out_size, void* d_ws, size_t ws_size, hipStream_t stream) {
    static int grid = 0;
    if (grid == 0) {
        if (n_in != 22 || (size_t)out_size != O_END || ws_size < WS_END_MIN) { fprintf(stderr, "kernel_launch: unexpected shapes n_in %d out %d ws %zu\n", n_in, out_size, ws_size); grid = -1; return; }
        int dev = 0, cus = 0;
        if (hipGetDevice(&dev) != hipSuccess || hipDeviceGetAttribute(&cus, hipDeviceAttributeMultiprocessorCount, dev) != hipSuccess) { grid = -1; return; }
        if (hipFuncSetAttribute((const void*)fwd, hipFuncAttributeMaxDynamicSharedMemorySize, LDS_BYTES) != hipSuccess) { fprintf(stderr, "kernel_launch: hipFuncSetAttribute failed\n"); grid = -1; return; }
        int per_cu = 0;
        if (hipOccupancyMaxActiveBlocksPerMultiprocessor(&per_cu, (const void*)fwd, NT, LDS_BYTES) != hipSuccess || per_cu < 1) { fprintf(stderr, "kernel_launch: occupancy query says %d\n", per_cu); }
        (void)hipGetLastError();
        grid = cus;
    }
    if (grid < 0) return;
    (void)hipMemsetAsync((char*)d_ws + WS_CTL, 0, CTL_ZERO_BYTES, stream);
    Args a{};
    for (int i = 0; i < 22; ++i) a.in[i] = (const float*)d_in[i];
    a.out = (float*)d_out; a.ws = (unsigned char*)d_ws;
#if defined(PROBE_PHASE)
    { const int cuts[4] = {0, PROBE_PHASE + 1, PROBE_PHASE + 1, NPH}; const int los[3] = {0, PROBE_PHASE, PROBE_PHASE + 1};
      for (int li = 0; li < 3; ++li) { a.ph_lo = los[li]; a.ph_hi = cuts[li + 1]; if (a.ph_lo >= a.ph_hi) continue;
          if (li) { (void)hipMemsetAsync((char*)d_ws + WS_CTL + CW_BAR * 4, 0, XCD_BAR_WORDS * 4, stream); (void)hipMemsetAsync((char*)d_ws + WS_CTL + CW_Q * 4, 0, 4096, stream); }
          hipLaunchKernelGGL(fwd, dim3(grid), dim3(NT), LDS_BYTES, stream, a); } }
#elif N_LAUNCHES == 1
    a.ph_lo = 0; a.ph_hi = NPH;
    hipLaunchKernelGGL(fwd, dim3(grid), dim3(NT), LDS_BYTES, stream, a);
#else
    for (int p = 0; p < NPH; ++p) {
        a.ph_lo = p; a.ph_hi = p + 1;
        hipLaunchKernelGGL(fwd, dim3(grid), dim3(NT), LDS_BYTES, stream, a);
    }
#endif
}
```

```cpp
#define N_LAUNCHES 1
#define ACT_T bf16_t
#define BR_T bf16_t
#define USE_MFMA_GEMM 1
#define USE_MFMA_ATTN 1
#define USE_GDN_CHUNK 1
#define OP_SPLIT 1
#include <hip/hip_runtime.h>
#include <cstdio>
#include <cstdint>

#define GAS __attribute__((address_space(1)))
#define LAS __attribute__((address_space(3)))
typedef unsigned short bf16_t;
typedef float f32x4 __attribute__((ext_vector_type(4)));
typedef float f32x2 __attribute__((ext_vector_type(2)));
typedef float f32x16 __attribute__((ext_vector_type(16)));
typedef short bf16x8 __attribute__((ext_vector_type(8)));
typedef short s16x4 __attribute__((ext_vector_type(4)));
typedef unsigned u32x4 __attribute__((ext_vector_type(4)));
typedef unsigned u32x2 __attribute__((ext_vector_type(2)));

constexpr int DM = 2048, NB = 2, SEQ = 8192, DEPTH = 4, DB = 32, DS = 16, PAST = 1024;
constexpr int HD = 128, NH = 12, MIXW = NH * HD  , NMH = 4, MEMW = NMH * HD  , BRW = 2048, NMEM = 256;
constexpr int CONVW = 4, CONVCH = 3 * MIXW  ;
constexpr int FOX_IN = 3 * MIXW + NH + MEMW + BRW  , GDN_IN = 3 * MIXW + 2 * NH + MEMW + BRW  ;
constexpr int MP = NB * SEQ  , MS = DB * DS  , MR = MP + MS  ;
constexpr int NIN = 7424;
constexpr int C_QM = 4608, C_Z = 5120, C_G = 7168;
constexpr float EPS = 1e-6f;
constexpr float ATT_SCALE = 0.08838834764831845f;
constexpr int FS_LEN = 1088;

constexpr size_t O_YP = 0;
constexpr size_t O_YS = O_YP + (size_t)MP * DM;
constexpr size_t O_PFK = O_YS + (size_t)MS * DM;
constexpr size_t O_PFV = O_PFK + (size_t)2 * MP * MIXW;
constexpr size_t O_PFL = O_PFV + (size_t)2 * MP * MIXW;
constexpr size_t O_PGS = O_PFL + (size_t)2 * MP * NH;
constexpr size_t O_PGC = O_PGS + (size_t)2 * NB * NH * HD * HD;
constexpr size_t O_PMK = O_PGC + (size_t)2 * NB * 3 * CONVCH;
constexpr size_t O_PMV = O_PMK + (size_t)DEPTH * NB * NMEM * MEMW;
constexpr size_t O_SFK = O_PMV + (size_t)DEPTH * NB * NMEM * MEMW;
constexpr size_t O_SFV = O_SFK + (size_t)2 * MS * MIXW;
constexpr size_t O_SFL = O_SFV + (size_t)2 * MS * MIXW;
constexpr size_t O_SGS = O_SFL + (size_t)2 * MS * NH;
constexpr size_t O_SGC = O_SGS + (size_t)2 * DB * NH * HD * HD;
constexpr size_t O_END = O_SGC + (size_t)2 * DB * 3 * CONVCH;
static_assert(O_END == 155224064ull, "output size");

constexpr size_t MiB = 1ull << 20;
constexpr size_t WS_CTL = 0, CTL_ZERO_BYTES = 1 * MiB;
constexpr size_t WS_WTIN = 2 * MiB;
constexpr size_t WTIN_L = (size_t)NIN * DM * 2;
constexpr size_t WS_WTOUT = WS_WTIN + 4 * WTIN_L;
constexpr size_t WTOUT_L = (size_t)DM * BRW * 2;
constexpr size_t WS_WTMKV = WS_WTOUT + 4 * WTOUT_L;
constexpr size_t WTMKV_L = (size_t)1024 * DM * 2;
constexpr size_t WS_HM = WS_WTMKV + 4 * WTMKV_L;
constexpr size_t HM_L = (size_t)512 * DM * 2;
constexpr size_t WS_H = WS_HM + 4 * HM_L;
constexpr size_t WS_QKV = WS_H + (size_t)MR * DM * 2;
constexpr size_t WS_QM = WS_QKV + (size_t)MR * CONVCH * 2;
constexpr size_t WS_ZS = WS_QM + (size_t)MR * MEMW * 2;
constexpr size_t WS_BR = WS_ZS + (size_t)MR * BRW * 2;
constexpr size_t WS_GA = WS_BR + (size_t)MR * BRW * 2;
constexpr size_t WS_BETA = WS_GA + (size_t)MR * NH * 4;
constexpr size_t WS_FP = WS_BETA + (size_t)MR * NH * 4;
constexpr size_t WS_FS = WS_FP + (size_t)NB * NH * SEQ * 4;
constexpr size_t WS_PART = ((WS_FS + (size_t)DB * NH * FS_LEN * 4 + MiB - 1) / MiB) * MiB;
#ifndef OP_KS_
#define OP_KS_ 8
#endif
constexpr int OP_KS = OP_KS_;
constexpr size_t WS_GDN = WS_PART + 64 * MiB; constexpr size_t WS_GDN_OLD_ = ((WS_FS + (size_t)DB * NH * FS_LEN * 4 + MiB - 1) / MiB) * MiB;
constexpr size_t WS_END_MIN = WS_GDN + 640 * MiB;

constexpr size_t WS_ZERO = 512 * 1024;
constexpr int CW_KN = 12288;
constexpr size_t WS_QN = 768 * 1024;
constexpr int CW_TMO = 0, CW_CODE = 1, CW_BAR = 4096, CW_Q = 16384;

__device__ __forceinline__ float bf2f(bf16_t v) { return __uint_as_float((unsigned)v << 16); }
__device__ __forceinline__ bf16_t f2bf(float f) { unsigned u = __float_as_uint(f); return (bf16_t)((u + 0x7fffu + ((u >> 16) & 1u)) >> 16); }
__device__ __forceinline__ unsigned pk2(float lo, float hi) { return (unsigned)f2bf(lo) | ((unsigned)f2bf(hi) << 16); }
__device__ __forceinline__ float ldf(const float* p) { return *p; }
__device__ __forceinline__ float ldf(const bf16_t* p) { return bf2f(*p); }
__device__ __forceinline__ void stf(float* p, float v) { *p = v; }
__device__ __forceinline__ void stf(bf16_t* p, float v) { *p = f2bf(v); }
__device__ __forceinline__ float shfl_xor_l(float v, int off, int lane) { return __int_as_float(__builtin_amdgcn_ds_bpermute((lane ^ off) << 2, __float_as_int(v))); }
__device__ __forceinline__ float wave_sum(float v, int lane) {
#pragma unroll
    for (int o = 1; o < 64; o <<= 1) v += shfl_xor_l(v, o, lane);
    return v;
}
__device__ __forceinline__ float siluf(float x) { return x / (1.f + __expf(-x)); }
__device__ __forceinline__ float softplusf(float x) { return fmaxf(x, 0.f) + log1pf(__expf(-fabsf(x))); }
__device__ __forceinline__ float logsigmoidf(float x) { return -softplusf(-x); }
__device__ __forceinline__ float sigmoidf_(float x) { return 1.f / (1.f + __expf(-x)); }

#define XB_TMO      128
#define XB_XCNT(j)  (256  + 64 * (j))
#define XB_XSUB(j)  (1280 + 64 * (j))
#define XB_XGEN(j)  (2304 + 64 * (j))
#define XB_TOP      3328
#define XB_TOPGEN   3392
#define XCD_BAR_WORDS 3456
#define XB_SPIN_CAP (1u << 19)
__device__ __forceinline__ unsigned xb_ld(unsigned* p)              { return __hip_atomic_load(p, __ATOMIC_RELAXED, __HIP_MEMORY_SCOPE_AGENT); }
__device__ __forceinline__ unsigned xb_add(unsigned* p, unsigned v) { return __hip_atomic_fetch_add(p, v, __ATOMIC_RELAXED, __HIP_MEMORY_SCOPE_AGENT); }
__device__ __forceinline__ unsigned xb_xcc_id() { return (unsigned)__builtin_amdgcn_s_getreg((3 << 11) | 20) & 0xFu; }
#define XB_SPIN(cond, bar) do { unsigned _sp = 0; while (cond) { __builtin_amdgcn_s_sleep(1); \
    if ((++_sp & 255u) == 0u) { if (xb_ld(&(bar)[XB_TMO])) break; if (_sp > XB_SPIN_CAP) { atomicAdd(&(bar)[XB_TMO], 1u); break; } } } } while (0)
struct XcdBarrier { unsigned* bar; unsigned x; volatile LAS unsigned* st; };
__device__ __forceinline__ XcdBarrier xcd_barrier_post(unsigned* bar, volatile LAS unsigned* st, int tid) {
    XcdBarrier b; b.bar = bar; b.x = xb_xcc_id(); b.st = st;
    if (tid == 0) (void)xb_add(&bar[XB_XCNT(b.x)], 1u);
    return b;
}
__device__ __forceinline__ void xcd_barrier_complete(unsigned* bar, unsigned x, unsigned& nloc, unsigned& nx) {
    const unsigned G = gridDim.x * gridDim.y * gridDim.z;
    unsigned sum, cnt, mine, sp = 0u;
    for (;;) {
        sum = 0u; cnt = 0u; mine = 0u;
#pragma unroll
        for (unsigned j = 0; j < 16; ++j) { const unsigned c = xb_ld(&bar[XB_XCNT(j)]); sum += c; cnt += (c > 0u) ? 1u : 0u; mine = (j == x) ? c : mine; }
        if (sum == G) break;
        __builtin_amdgcn_s_sleep(1);
        if ((++sp & 255u) == 0u) { if (xb_ld(&bar[XB_TMO])) break; if (sp > XB_SPIN_CAP) { atomicAdd(&bar[XB_TMO], 1u); break; } }
    }
    nloc = mine > 0u ? mine : 1u; nx = cnt > 0u ? cnt : 1u;
}
__device__ __forceinline__ void xcd_barrier(const XcdBarrier& b, int tid) {
    asm volatile("s_waitcnt vmcnt(0)" ::: "memory");
    __syncthreads();
    if (tid == 0) {
        unsigned* bar = b.bar;
        __builtin_amdgcn_s_waitcnt(0);
        unsigned nloc = b.st[0], nx = b.st[1];
        if (nloc == 0u) { xcd_barrier_complete(bar, b.x, nloc, nx); b.st[0] = nloc; b.st[1] = nx; }
        const unsigned old = xb_add(&bar[XB_XSUB(b.x)], 1u);
        const unsigned gen = old / nloc;
        if (old + 1u == (gen + 1u) * nloc) {
            __builtin_amdgcn_fence(__ATOMIC_RELEASE, "agent");
            asm volatile("s_waitcnt vmcnt(0)" ::: "memory");
            const unsigned og = xb_add(&bar[XB_TOP], 1u);
            const unsigned tg = og / nx;
            if (og + 1u == (tg + 1u) * nx) xb_add(&bar[XB_TOPGEN], 1u);
            else XB_SPIN(xb_ld(&bar[XB_TOPGEN]) == tg, bar);
            __builtin_amdgcn_fence(__ATOMIC_ACQUIRE, "agent");
            xb_add(&bar[XB_XGEN(b.x)], 1u);
            asm volatile("s_waitcnt vmcnt(0)" ::: "memory");
        } else {
            XB_SPIN(xb_ld(&bar[XB_XGEN(b.x)]) == gen, bar);
            __builtin_amdgcn_fence(__ATOMIC_ACQUIRE, "agent");
            asm volatile("s_waitcnt vmcnt(0)" ::: "memory");
        }
    }
    __syncthreads();
}
#ifndef OP_SPLIT
#define OP_SPLIT 0
#endif
typedef ACT_T act_t;
typedef BR_T br_t;
constexpr int NT = 512;
constexpr int NWAVES = 8;

constexpr int PTR_OFF = 131072 + 512;
struct Frame {
    LAS unsigned char* lds;
    int tid, lane, wave, G, bid;
    __device__ __forceinline__ unsigned long long ptr(int i) const {
        const volatile LAS unsigned* t = (const volatile LAS unsigned*)(lds + PTR_OFF) + 2 * i;
        const unsigned lo = __builtin_amdgcn_readfirstlane(t[0]), hi = __builtin_amdgcn_readfirstlane(t[1]);
        return ((unsigned long long)hi << 32) | lo;
    }
    __device__ __forceinline__ const float* in(int i) const { return (const float*)(const GAS float*)ptr(i); }
    __device__ __forceinline__ float* out() const { return (float*)(GAS float*)ptr(22); }
    __device__ __forceinline__ unsigned char* ws() const { return (unsigned char*)(GAS unsigned char*)ptr(23); }
    __device__ __forceinline__ unsigned* ctl() const { return (unsigned*)(ws() + WS_CTL); }
    __device__ __forceinline__ bf16_t* wt_in(int L) const { return (bf16_t*)(ws() + WS_WTIN + (size_t)L * WTIN_L); }
    __device__ __forceinline__ bf16_t* wt_out(int L) const { return (bf16_t*)(ws() + WS_WTOUT + (size_t)L * WTOUT_L); }
    __device__ __forceinline__ bf16_t* wt_mkv(int L) const { return (bf16_t*)(ws() + WS_WTMKV + (size_t)L * WTMKV_L); }
    __device__ __forceinline__ bf16_t* hm(int L) const { return (bf16_t*)(ws() + WS_HM + (size_t)L * HM_L); }
    __device__ __forceinline__ bf16_t* h() const { return (bf16_t*)(ws() + WS_H); }
    __device__ __forceinline__ act_t* qkv() const { return (act_t*)(ws() + WS_QKV); }
    __device__ __forceinline__ act_t* qm() const { return (act_t*)(ws() + WS_QM); }
    __device__ __forceinline__ act_t* zs() const { return (act_t*)(ws() + WS_ZS); }
    __device__ __forceinline__ br_t* br() const { return (br_t*)(ws() + WS_BR); }
    __device__ __forceinline__ float* ga() const { return (float*)(ws() + WS_GA); }
    __device__ __forceinline__ float* beta() const { return (float*)(ws() + WS_BETA); }
    __device__ __forceinline__ float* fp() const { return (float*)(ws() + WS_FP); }
    __device__ __forceinline__ float* fs() const { return (float*)(ws() + WS_FS); }
};

__host__ __device__ __forceinline__ int inproj_src_col(int L, int n) {
    const int ng = (L & 1) ? 2 * NH : NH;
    if (n < CONVCH) return n;
    if (n < C_G) return n + ng;
    if (n < C_G + ng) return n - C_G + CONVCH;
    return -1;
}

__device__ __forceinline__ void transpose_tile(Frame& F, const float* W, int ldw, int k0, int n0, bf16_t* WT, int K, int L, int kind  ) {
    LAS float* t = (LAS float*)F.lds;
#pragma unroll
    for (int i = 0; i < 8; ++i) {
        const int idx = F.tid + NT * i, kk = idx >> 6, nn = idx & 63;
        const int sc = kind == 0 ? inproj_src_col(L, n0 + nn) : (n0 + nn);
        t[kk * 65 + nn] = sc >= 0 ? W[(size_t)(k0 + kk) * ldw + sc] : 0.f;
    }
    __syncthreads();
#pragma unroll
    for (int i = 0; i < 4; ++i) {
        const int idx = F.tid + NT * i, nn = idx >> 5, kp = idx & 31;
        const unsigned w = pk2(t[(2 * kp) * 65 + nn], t[(2 * kp + 1) * 65 + nn]);
        *(unsigned*)(WT + (size_t)(n0 + nn) * K + k0 + 2 * kp) = w;
    }
    __syncthreads();
}
__device__ __forceinline__ void rms_row_to_bf16(Frame& F, const float* xrow, const float* gain, bf16_t* orow) {
    const f32x4* xr = (const f32x4*)xrow + F.lane;
    const f32x4* gr = (const f32x4*)gain + F.lane;
    f32x4 v[8]; float s = 0.f;
#pragma unroll
    for (int j = 0; j < 8; ++j) { v[j] = xr[64 * j]; s += (v[j].x * v[j].x + v[j].y * v[j].y) + (v[j].z * v[j].z + v[j].w * v[j].w); }
    const float rstd = 1.f / sqrtf(wave_sum(s, F.lane) * (1.f / DM) + EPS);
    unsigned long long* o8 = (unsigned long long*)orow + F.lane;
#pragma unroll
    for (int j = 0; j < 8; ++j) { const f32x4 g = gr[64 * j];
        o8[64 * j] = (unsigned long long)pk2(v[j].x * rstd * g.x, v[j].y * rstd * g.y) | ((unsigned long long)pk2(v[j].z * rstd * g.z, v[j].w * rstd * g.w) << 32); }
}
__device__ __forceinline__ void convert_weights(Frame& F, int Lb, int Le, int wi, int nw) {
    constexpr int T_IN = 32 * (NIN / 64), T_OUT = 32 * (DM / 64), T_MKV = 32 * (1024 / 64), T_L = T_IN + T_OUT + T_MKV;
    for (int it = wi; it < (Le - Lb) * T_L; it += nw) {
        const int L = Lb + it / T_L; int r = it % T_L;
        if (r < T_IN) { const int kb = r / (NIN / 64), nb = r % (NIN / 64);
            const float* W = (L & 1) ? F.in(15) + (size_t)(L >> 1) * DM * GDN_IN : F.in(13) + (size_t)(L >> 1) * DM * FOX_IN;
            transpose_tile(F, W, (L & 1) ? GDN_IN : FOX_IN, kb * 64, nb * 64, F.wt_in(L), DM, L, 0); continue; }
        r -= T_IN;
        if (r < T_OUT) { const int kb = r / (DM / 64), nb = r % (DM / 64);
            transpose_tile(F, F.in(20) + (size_t)L * BRW * DM, DM, kb * 64, nb * 64, F.wt_out(L), BRW, L, 1); continue; }
        r -= T_OUT;
        { const int kb = r / 16, nb = r % 16;
            transpose_tile(F, F.in(12) + (size_t)L * DM * 1024, 1024, kb * 64, nb * 64, F.wt_mkv(L), DM, L, 1); }
    }
}
__device__ __forceinline__ void p_prologue(Frame& F) {
    convert_weights(F, 0, 2, F.bid, F.G);
    { constexpr int T_MKV = 32 * 16; for (int it = F.bid; it < 2 * T_MKV; it += F.G) { const int L = 2 + it / T_MKV, r = it % T_MKV;
        transpose_tile(F, F.in(12) + (size_t)L * DM * 1024, 1024, (r / 16) * 64, (r % 16) * 64, F.wt_mkv(L), DM, L, 1); } }
    const int gw = F.bid * NWAVES + F.wave, NGW = F.G * NWAVES;
    for (int m = gw; m < 4 * 512; m += NGW) { const int L = m >> 9, row = m & 511;
        rms_row_to_bf16(F, F.in(2) + (size_t)row * DM, F.in(11) + (size_t)L * DM, F.hm(L) + (size_t)row * DM); }
}
__device__ __forceinline__ void load_resid_row(Frame& F, int L, int r, f32x4 (&v)[8]) {
    if (L == 0) { const f32x4* xr = (const f32x4*)(r < MP ? F.in(0) + (size_t)r * DM : F.in(1) + (size_t)(r - MP) * DM) + F.lane;
#pragma unroll
        for (int j = 0; j < 8; ++j) v[j] = xr[64 * j];
        if (r >= MP) { f32x4* xo = (f32x4*)(F.out() + (size_t)r * DM) + F.lane;
#pragma unroll
            for (int j = 0; j < 8; ++j) xo[64 * j] = v[j]; }
        return; }
    f32x4* xr = (f32x4*)(F.out() + (size_t)r * DM) + F.lane;
#pragma unroll
    for (int j = 0; j < 8; ++j) v[j] = xr[64 * j];
    if (OP_SPLIT && r >= MP) { const f32x4* pp = (const f32x4*)(F.ws() + WS_PART) + (size_t)(r - MP) * (DM / 4) + F.lane;
#pragma unroll 1
        for (int s = 0; s < OP_KS; ++s) {
#pragma unroll
            for (int j = 0; j < 8; ++j) v[j] += pp[(size_t)s * MS * (DM / 4) + 64 * j]; }
#pragma unroll
        for (int j = 0; j < 8; ++j) xr[64 * j] = v[j]; }
}
__device__ __forceinline__ void p_norm(Frame& F, int L) {
    const int gw = F.bid * NWAVES + F.wave, NGW = F.G * NWAVES;
    for (int r = gw; r < MR; r += NGW) {
        f32x4 v[8]; load_resid_row(F, L, r, v);
        const f32x4* gr = (const f32x4*)(F.in(10) + (size_t)L * DM) + F.lane; float s = 0.f;
#pragma unroll
        for (int j = 0; j < 8; ++j) s += (v[j].x * v[j].x + v[j].y * v[j].y) + (v[j].z * v[j].z + v[j].w * v[j].w);
        const float rstd = 1.f / sqrtf(wave_sum(s, F.lane) * (1.f / DM) + EPS);
        unsigned long long* o8 = (unsigned long long*)(F.h() + (size_t)r * DM) + F.lane;
#pragma unroll
        for (int j = 0; j < 8; ++j) { const f32x4 g = gr[64 * j];
            o8[64 * j] = (unsigned long long)pk2(v[j].x * rstd * g.x, v[j].y * rstd * g.y) | ((unsigned long long)pk2(v[j].z * rstd * g.z, v[j].w * rstd * g.w) << 32); }
    }
}
__device__ __forceinline__ void p_final_norm(Frame& F) {
    const int gw = F.bid * NWAVES + F.wave, NGW = F.G * NWAVES;
    for (int r = gw; r < MR; r += NGW) {
        f32x4 v[8]; load_resid_row(F, 4, r, v);
        f32x4* xr = (f32x4*)(F.out() + (size_t)r * DM) + F.lane;
        const f32x4* gr = (const f32x4*)F.in(21) + F.lane; float s = 0.f;
#pragma unroll
        for (int j = 0; j < 8; ++j) s += (v[j].x * v[j].x + v[j].y * v[j].y) + (v[j].z * v[j].z + v[j].w * v[j].w);
        const float rstd = 1.f / sqrtf(wave_sum(s, F.lane) * (1.f / DM) + EPS);
#pragma unroll
        for (int j = 0; j < 8; ++j) { const f32x4 g = gr[64 * j]; xr[64 * j] = v[j] * rstd * g; }
    }
}

struct EpiInProj {
    int L; float* out; act_t* qkv; act_t* qm; act_t* zs; float* ga; float* beta; const float* bfor; const float* alog; const float* dtb;
    __device__ __forceinline__ void operator()(int r, int c, float v) const {
        const int j = L >> 1;
        if (c < CONVCH) {
            stf(qkv + (size_t)r * CONVCH + c, v);
            if (!(L & 1)) {
                if (c >= MIXW) { const int isv = c >= 2 * MIXW, cc = c - (isv ? 2 * MIXW : MIXW);
                    float* o = r < MP ? out + (isv ? O_PFV : O_PFK) + ((size_t)j * MP + r) * MIXW + cc
                                      : out + (isv ? O_SFV : O_SFK) + ((size_t)j * MS + (r - MP)) * MIXW + cc;
                    *o = v; }
            } else {
                if (r < MP) { const int t = r & (SEQ - 1), b = r >> 13; if (t >= SEQ - 3) out[O_PGC + (((size_t)j * NB + b) * 3 + (t - (SEQ - 3))) * CONVCH + c] = v; }
                else { const int s = r - MP, l = s & 15, bs = s >> 4; if (l >= DS - 3) out[O_SGC + (((size_t)j * DB + bs) * 3 + (l - (DS - 3))) * CONVCH + c] = v; }
            }
        } else if (c < C_Z) { stf(qm + (size_t)r * MEMW + (c - C_QM), v);
        } else if (c < C_G) { stf(zs + (size_t)r * BRW + (c - C_Z), siluf(v));
        } else if (!(L & 1)) {
            if (c < C_G + NH) { const int hh = c - C_G; const float lf = logsigmoidf(v + bfor[j * NH + hh]);
                if (r < MP) out[O_PFL + ((size_t)j * MP + r) * NH + hh] = lf; else out[O_SFL + ((size_t)j * MS + (r - MP)) * NH + hh] = lf; }
        } else {
            if (c < C_G + NH) { const int hh = c - C_G;
                ga[(size_t)r * NH + hh] = -__expf(alog[j * NH + hh]) * softplusf(v + dtb[j * NH + hh]); }
            else if (c < C_G + 2 * NH) { const int hh = c - C_G - NH; beta[(size_t)r * NH + hh] = sigmoidf_(v); }
        }
    }
};
__device__ __forceinline__ EpiInProj mk_epi_inproj(const Frame& F, int L) {
    EpiInProj e; e.L = L; e.out = F.out(); e.qkv = F.qkv(); e.qm = F.qm(); e.zs = F.zs(); e.ga = F.ga(); e.beta = F.beta(); e.bfor = F.in(14); e.alog = F.in(17); e.dtb = F.in(18); return e;
}
struct EpiOutProj {
    int L; float* out; const float* xp; const float* xs;
    __device__ __forceinline__ void operator()(int r, int c, float v) const {
        const float xo = L == 0 ? (r < MP ? xp[(size_t)r * DM + c] : xs[(size_t)(r - MP) * DM + c]) : out[(size_t)r * DM + c];
        out[(size_t)r * DM + c] = xo + v;
    }
};
struct EpiMemKV {
    int L; float* out;
    __device__ __forceinline__ void operator()(int r, int c, float v) const {
        if (c < MEMW) out[O_PMK + ((size_t)L * 512 + r) * MEMW + c] = v; else out[O_PMV + ((size_t)L * 512 + r) * MEMW + (c - MEMW)] = v;
    }
};

template <class TA, class Epi>
__device__ __forceinline__ void gemm_naive_tile(Frame& F, const TA* A, const bf16_t* Bt, int K, int pm, int pn, const Epi& epi) {
    LAS float* As = (LAS float*)F.lds;
    LAS float* Bs = As + 32 * 132;
    const int ty = F.tid >> 5, tx = F.tid & 31;
    float acc[8][4];
#pragma unroll
    for (int i = 0; i < 8; ++i)
#pragma unroll
        for (int j = 0; j < 4; ++j) acc[i][j] = 0.f;
    for (int k0 = 0; k0 < K; k0 += 32) {
#pragma unroll
        for (int i = 0; i < 8; ++i) { const int idx = F.tid + NT * i, row = idx >> 5, kk = idx & 31;
            As[kk * 132 + row] = ldf(A + (size_t)(pm * 128 + row) * K + k0 + kk);
            Bs[kk * 132 + row] = bf2f(Bt[(size_t)(pn * 128 + row) * K + k0 + kk]); }
        __syncthreads();
#pragma unroll 8
        for (int kk = 0; kk < 32; ++kk) {
            const f32x4 a0 = *(const LAS f32x4*)(As + kk * 132 + ty * 8), a1 = *(const LAS f32x4*)(As + kk * 132 + ty * 8 + 4);
            const f32x4 b = *(const LAS f32x4*)(Bs + kk * 132 + tx * 4);
            const float a[8] = {a0.x, a0.y, a0.z, a0.w, a1.x, a1.y, a1.z, a1.w};
#pragma unroll
            for (int i = 0; i < 8; ++i) { acc[i][0] += a[i] * b.x; acc[i][1] += a[i] * b.y; acc[i][2] += a[i] * b.z; acc[i][3] += a[i] * b.w; }
        }
        __syncthreads();
    }
#pragma unroll
    for (int i = 0; i < 8; ++i)
#pragma unroll
        for (int j = 0; j < 4; ++j) epi(pm * 128 + ty * 8 + i, pn * 128 + tx * 4 + j, acc[i][j]);
}
template <class TA, class Epi>
__device__ __forceinline__ void gemm_naive(Frame& F, const TA* A, const bf16_t* Bt, int M, int N, int K, const Epi& epi) {
    const int ntn = N / 128, nt = (M / 128) * ntn;
    for (int t = F.bid; t < nt; t += F.G) gemm_naive_tile(F, A, Bt, K, t / ntn, t % ntn, epi);
}

__device__ __forceinline__ float block_excl_prefix(Frame& F, float s) {
    LAS float* wsum = (LAS float*)F.lds;
    float incl = s;
#pragma unroll
    for (int o = 1; o < 64; o <<= 1) { const float up = __int_as_float(__builtin_amdgcn_ds_bpermute(((F.lane - o) & 63) << 2, __float_as_int(incl))); if (F.lane >= o) incl += up; }
    __syncthreads();
    if (F.lane == 63) wsum[F.wave] = incl;
    __syncthreads();
    float base = 0.f;
#pragma unroll
    for (int w = 0; w < 8; ++w) if (w < F.wave) base += wsum[w];
    return base + incl - s;
}
__device__ __forceinline__ void cumsum_unit(Frame& F, int j, int u) {
    if (u < NB * NH) {
        const int b = u / NH, hh = u % NH;
        const float* src = F.out() + O_PFL + ((size_t)j * MP + (size_t)b * SEQ) * NH + hh;
        float v[16]; float s = 0.f;
#pragma unroll
        for (int i = 0; i < 16; ++i) { v[i] = src[(size_t)(F.tid * 16 + i) * NH]; s += v[i]; }
        float run = block_excl_prefix(F, s); float* dst = F.fp() + ((size_t)b * NH + hh) * SEQ + F.tid * 16;
#pragma unroll
        for (int i = 0; i < 16; ++i) { run += v[i]; dst[i] = run; }
    } else {
        const int s_ = u - NB * NH, bs = s_ / NH, hh = s_ % NH;
        const float* c = F.in(5) + (((size_t)j * DB + bs) * PAST) * NH + hh;
        const float* nw = F.out() + O_SFL + ((size_t)j * MS + (size_t)bs * DS) * NH + hh;
        float v[4] = {0.f, 0.f, 0.f, 0.f}; float s = 0.f;
        if (F.tid < 260) {
#pragma unroll
            for (int i = 0; i < 4; ++i) { const int p = F.tid * 4 + i; v[i] = p < PAST ? c[(size_t)p * NH] : nw[(size_t)(p - PAST) * NH]; s += v[i]; } }
        float run = block_excl_prefix(F, s);
        float* dst = F.fs() + ((size_t)bs * NH + hh) * FS_LEN;
        if (F.tid < 260) {
#pragma unroll
            for (int i = 0; i < 4; ++i) { run += v[i]; dst[F.tid * 4 + i] = run; } }
        else if (F.tid < 272) {
#pragma unroll
            for (int i = 0; i < 4; ++i) dst[F.tid * 4 + i] = run; }
    }
}
__device__ __forceinline__ void qknorm_unit(Frame& F, int L, int u) {
    const int qb = u & 31, bh = u >> 5, b = bh / NH, hh = bh % NH;
    LAS float* red = (LAS float*)F.lds;
    const bf16_t* base = (const bf16_t*)F.qkv() + ((size_t)b * SEQ + (size_t)qb * 256 + (F.tid >> 1)) * CONVCH + hh * HD + (F.tid & 1) * 64;
    float sq = 0.f, sk = 0.f;
#pragma unroll
    for (int c = 0; c < 8; ++c) { const bf16x8 qv = *(const bf16x8*)(base + 8 * c), kv = *(const bf16x8*)(base + MIXW + 8 * c);
#pragma unroll
        for (int e = 0; e < 8; ++e) { const float a = __uint_as_float((unsigned)(unsigned short)qv[e] << 16), k = __uint_as_float((unsigned)(unsigned short)kv[e] << 16); sq += a * a; sk += k * k; } }
    sq += shfl_xor_l(sq, 1, F.lane); sk += shfl_xor_l(sk, 1, F.lane);
#pragma unroll
    for (int o = 2; o < 64; o <<= 1) { sq = fmaxf(sq, shfl_xor_l(sq, o, F.lane)); sk = fmaxf(sk, shfl_xor_l(sk, o, F.lane)); }
    __syncthreads();
    if (F.lane == 0) { red[F.wave] = sq; red[8 + F.wave] = sk; }
    __syncthreads();
    if (F.tid == 0) { float mq = red[0], mk = red[8];
#pragma unroll
        for (int w = 1; w < 8; ++w) { mq = fmaxf(mq, red[w]); mk = fmaxf(mk, red[8 + w]); }
        ((float*)(F.ws() + WS_QN))[bh * 32 + qb] = mq;
        atomicMax(F.ctl() + CW_KN + L * 32 + bh, __float_as_uint(mk)); }
}
__device__ __forceinline__ void p_cumsum(Frame& F, int L) {
    const int j = L >> 1; const int n1 = NB * NH + DB * NH;
    for (int u = F.bid; u < n1 + NB * NH * 32; u += F.G) { if (u < n1) cumsum_unit(F, j, u); else qknorm_unit(F, L, u - n1); }
}

struct NAttn {
    const act_t* Q; int q_stride;
    const float* K1; const float* V1; int s1, n1;
    const float* K2; const float* V2; int s2;
    int nkeys; const float* Fk;
    int pos0;
    int nrows;
    br_t* O; const act_t* Z; int o_stride;
};
__device__ __forceinline__ void nattn_unit(Frame& F, const NAttn& a) {
    LAS float* Qs = (LAS float*)F.lds;
    LAS float* Ks = Qs + 16 * 128;
    LAS float* Vs = Ks + 64 * 129;
    LAS float* Ps = Vs + 64 * 128;
    const int qi = F.tid >> 5, kl = F.tid & 31;
    __syncthreads();
#pragma unroll
    for (int i = 0; i < 4; ++i) { const int idx = F.tid + NT * i, r = idx >> 7, d = idx & 127;
        Qs[idx] = r < a.nrows ? ldf(a.Q + (size_t)r * a.q_stride + d) : 0.f; }
    float o[4] = {0.f, 0.f, 0.f, 0.f}; float m_run = -1e30f, l_run = 0.f;
    const int pos = a.pos0 + qi;
    const float fq = (a.Fk && qi < a.nrows) ? a.Fk[pos < a.nkeys ? pos : a.nkeys - 1] : 0.f;
    int jmax = a.pos0 + a.nrows; if (jmax > a.nkeys) jmax = a.nkeys;
    for (int j0 = 0; j0 < jmax; j0 += 64) {
        __syncthreads();
#pragma unroll 2
        for (int i = 0; i < 16; ++i) { const int kr = (F.tid >> 7) + 4 * i, d = F.tid & 127, j = j0 + kr;
            float kv = 0.f, vv = 0.f;
            if (j < a.nkeys) { const bool first = j < a.n1; const float* kp = first ? a.K1 : a.K2; const float* vp = first ? a.V1 : a.V2;
                const size_t off = first ? (size_t)j * a.s1 + d : (size_t)(j - a.n1) * a.s2 + d; kv = kp[off]; vv = vp[off]; }
            Ks[kr * 129 + d] = kv; Vs[kr * 128 + d] = vv; }
        __syncthreads();
        float s[2];
#pragma unroll
        for (int e = 0; e < 2; ++e) { const int kk = kl + 32 * e, j = j0 + kk; float acc = 0.f;
            for (int d = 0; d < 128; ++d) acc += Qs[qi * 128 + d] * Ks[kk * 129 + d];
            const bool ok = j < a.nkeys && j <= pos && qi < a.nrows;
            float bias = 0.f; if (a.Fk && ok) bias = fq - a.Fk[j];
            s[e] = ok ? acc * ATT_SCALE + bias : -__builtin_inff(); }
        float mt = fmaxf(s[0], s[1]);
#pragma unroll
        for (int off = 16; off >= 1; off >>= 1) mt = fmaxf(mt, shfl_xor_l(mt, off, F.lane));
        const float m_new = fmaxf(m_run, mt), alpha = __expf(m_run - m_new);
        const float p0 = __expf(s[0] - m_new), p1 = __expf(s[1] - m_new);
        float ps = p0 + p1;
#pragma unroll
        for (int off = 16; off >= 1; off >>= 1) ps += shfl_xor_l(ps, off, F.lane);
        l_run = l_run * alpha + ps; m_run = m_new;
        Ps[qi * 64 + kl] = p0; Ps[qi * 64 + kl + 32] = p1;
#pragma unroll
        for (int c = 0; c < 4; ++c) o[c] *= alpha;
        __syncthreads();
        for (int kk = 0; kk < 64; ++kk) { const float p = Ps[qi * 64 + kk]; const f32x4 v = *(const LAS f32x4*)(Vs + kk * 128 + kl * 4);
            o[0] += p * v.x; o[1] += p * v.y; o[2] += p * v.z; o[3] += p * v.w; }
    }
    if (qi < a.nrows) { const float inv = 1.f / l_run;
#pragma unroll
        for (int c = 0; c < 4; ++c) { const size_t off = (size_t)qi * a.o_stride + kl * 4 + c; stf(a.O + off, o[c] * inv * ldf(a.Z + off)); } }
    __syncthreads();
}
__device__ __forceinline__ NAttn mk_fox_prompt(Frame& F, int L, int b, int hh, int row0, int nrows) {
    const int j = L >> 1; NAttn a;
    a.Q = F.qkv() + ((size_t)b * SEQ + row0) * CONVCH + hh * HD; a.q_stride = CONVCH;
    a.K1 = F.out() + O_PFK + ((size_t)j * MP + (size_t)b * SEQ) * MIXW + hh * HD; a.V1 = F.out() + O_PFV + ((size_t)j * MP + (size_t)b * SEQ) * MIXW + hh * HD;
    a.s1 = MIXW; a.n1 = SEQ; a.K2 = a.K1; a.V2 = a.V1; a.s2 = MIXW; a.nkeys = SEQ;
    a.Fk = F.fp() + ((size_t)b * NH + hh) * SEQ; a.pos0 = row0; a.nrows = nrows;
    a.O = F.br() + ((size_t)b * SEQ + row0) * BRW + hh * HD; a.Z = F.zs() + ((size_t)b * SEQ + row0) * BRW + hh * HD; a.o_stride = BRW;
    return a;
}
__device__ __forceinline__ NAttn mk_fox_sample(Frame& F, int L, int bs, int hh) {
    const int j = L >> 1; NAttn a; const size_t r0 = (size_t)MP + (size_t)bs * DS;
    a.Q = F.qkv() + r0 * CONVCH + hh * HD; a.q_stride = CONVCH;
    a.K1 = F.in(3) + (((size_t)j * DB + bs) * PAST) * MIXW + hh * HD; a.V1 = F.in(4) + (((size_t)j * DB + bs) * PAST) * MIXW + hh * HD; a.s1 = MIXW; a.n1 = PAST;
    a.K2 = F.out() + O_SFK + ((size_t)j * MS + (size_t)bs * DS) * MIXW + hh * HD; a.V2 = F.out() + O_SFV + ((size_t)j * MS + (size_t)bs * DS) * MIXW + hh * HD; a.s2 = MIXW;
    a.nkeys = PAST + DS; a.Fk = F.fs() + ((size_t)bs * NH + hh) * FS_LEN; a.pos0 = PAST; a.nrows = DS;
    a.O = F.br() + r0 * BRW + hh * HD; a.Z = F.zs() + r0 * BRW + hh * HD; a.o_stride = BRW;
    return a;
}
__device__ __forceinline__ NAttn mk_mem_prompt(Frame& F, int L, int b, int hm, int row0, int nrows) {
    NAttn a;
    a.Q = F.qm() + ((size_t)b * SEQ + row0) * MEMW + hm * HD; a.q_stride = MEMW;
    a.K1 = F.out() + O_PMK + ((size_t)L * 512 + (size_t)b * NMEM) * MEMW + hm * HD; a.V1 = F.out() + O_PMV + ((size_t)L * 512 + (size_t)b * NMEM) * MEMW + hm * HD;
    a.s1 = MEMW; a.n1 = NMEM; a.K2 = a.K1; a.V2 = a.V1; a.s2 = MEMW; a.nkeys = NMEM; a.Fk = nullptr; a.pos0 = NMEM; a.nrows = nrows;
    a.O = F.br() + ((size_t)b * SEQ + row0) * BRW + MIXW + hm * HD; a.Z = F.zs() + ((size_t)b * SEQ + row0) * BRW + MIXW + hm * HD; a.o_stride = BRW;
    return a;
}
__device__ __forceinline__ NAttn mk_mem_sample(Frame& F, int L, int bs, int hm) {
    NAttn a; const size_t r0 = (size_t)MP + (size_t)bs * DS;
    a.Q = F.qm() + r0 * MEMW + hm * HD; a.q_stride = MEMW;
    a.K1 = F.in(8) + (((size_t)L * DB + bs) * NMEM) * MEMW + hm * HD; a.V1 = F.in(9) + (((size_t)L * DB + bs) * NMEM) * MEMW + hm * HD;
    a.s1 = MEMW; a.n1 = NMEM; a.K2 = a.K1; a.V2 = a.V1; a.s2 = MEMW; a.nkeys = NMEM; a.Fk = nullptr; a.pos0 = NMEM; a.nrows = DS;
    a.O = F.br() + r0 * BRW + MIXW + hm * HD; a.Z = F.zs() + r0 * BRW + MIXW + hm * HD; a.o_stride = BRW;
    return a;
}

struct NGdn {
    int j, hh; size_t row0; int nT;
    const float* hist;
    const float* S0;
    float* Sout;
};
__device__ __forceinline__ void ngdn_unit(Frame& F, const NGdn& u) {
    LAS float* raw = (LAS float*)F.lds;
    LAS float* qs = raw + 384;
    LAS float* ks = qs + 128;
    LAS float* vs = ks + 128;
    LAS float* red = vs + 128;
    LAS float* red2 = red + 512;
    LAS float* wsum = red2 + 512;
    const int dvc = F.tid & 127, dkg = F.tid >> 7;
    const float* cw = F.in(16) + (size_t)u.j * CONVW * CONVCH;
    const float* gain = F.in(19) + (size_t)u.j * HD;
    float S[32];
#pragma unroll
    for (int i = 0; i < 32; ++i) S[i] = u.S0 ? u.S0[(size_t)(dkg * 32 + i) * HD + dvc] : 0.f;
    const int sel = F.tid >> 7;
    const int col = sel * MIXW + u.hh * HD + (F.tid & 127);
    float w4[4] = {0.f, 0.f, 0.f, 0.f};
    if (F.tid < 384) {
#pragma unroll
        for (int jj = 0; jj < 4; ++jj) w4[jj] = cw[(size_t)jj * CONVCH + col]; }
    __syncthreads();
    for (int t = 0; t < u.nT; ++t) {
        const size_t row = u.row0 + t;
        float val = 0.f;
        if (F.tid < 384) { float y = 0.f;
#pragma unroll
            for (int jj = 0; jj < 4; ++jj) { const int tau = t - 3 + jj; float x;
                if (tau >= 0) x = ldf(F.qkv() + (u.row0 + tau) * CONVCH + col); else x = u.hist ? u.hist[(size_t)(3 + tau) * CONVCH + col] : 0.f;
                y += w4[jj] * x; }
            val = siluf(y); raw[F.tid] = val; }
        const float sq = wave_sum(val * val, F.lane);
        if (F.lane == 0) wsum[F.wave] = sq;
        __syncthreads();
        const float nq = wsum[0] + wsum[1], nk = wsum[2] + wsum[3];
        if (F.tid < 128) qs[F.tid] = raw[F.tid] * (1.f / sqrtf(nq + EPS)) * ATT_SCALE;
        else if (F.tid < 256) ks[F.tid - 128] = raw[F.tid] * (1.f / sqrtf(nk + EPS));
        else if (F.tid < 384) vs[F.tid - 256] = raw[F.tid];
        __syncthreads();
        const float g = F.ga()[row * NH + u.hh], beta = F.beta()[row * NH + u.hh], eg = __expf(g);
        float part = 0.f;
#pragma unroll
        for (int i = 0; i < 32; ++i) part += ks[dkg * 32 + i] * S[i];
        red[dkg * 128 + dvc] = part;
        __syncthreads();
        const float kS = (red[dvc] + red[128 + dvc] + red[256 + dvc] + red[384 + dvc]) * eg;
        const float vnew = beta * (vs[dvc] - kS);
        float po = 0.f;
#pragma unroll
        for (int i = 0; i < 32; ++i) { S[i] = eg * S[i] + ks[dkg * 32 + i] * vnew; po += qs[dkg * 32 + i] * S[i]; }
        red2[dkg * 128 + dvc] = po;
        __syncthreads();
        float o = 0.f, so = 0.f;
        if (F.tid < 128) { o = red2[dvc] + red2[128 + dvc] + red2[256 + dvc] + red2[384 + dvc]; so = o * o; }
        const float ss = wave_sum(so, F.lane);
        if (F.lane == 0) wsum[F.wave] = ss;
        __syncthreads();
        if (F.tid < 128) { const float rstd = 1.f / sqrtf((wsum[0] + wsum[1]) * (1.f / HD) + EPS);
            const size_t off = row * BRW + u.hh * HD + dvc;
            stf(F.br() + off, o * rstd * gain[dvc] * ldf(F.zs() + off)); }
        __syncthreads();
    }
#pragma unroll
    for (int i = 0; i < 32; ++i) u.Sout[(size_t)(dkg * 32 + i) * HD + dvc] = S[i];
    __syncthreads();
}
__device__ __forceinline__ NGdn mk_gdn(Frame& F, int L, int u) {
    const int j = L >> 1; NGdn g; g.j = j;
    if (u < NB * NH) { const int b = u / NH, hh = u % NH; g.hh = hh; g.row0 = (size_t)b * SEQ; g.nT = SEQ; g.hist = nullptr; g.S0 = nullptr;
        g.Sout = F.out() + O_PGS + (((size_t)j * NB + b) * NH + hh) * HD * HD; }
    else { const int s = u - NB * NH, bs = s / NH, hh = s % NH; g.hh = hh; g.row0 = (size_t)MP + (size_t)bs * DS; g.nT = DS;
        g.hist = F.in(7) + ((size_t)j * DB + bs) * 3 * CONVCH; g.S0 = F.in(6) + (((size_t)j * DB + bs) * NH + hh) * HD * HD;
        g.Sout = F.out() + O_SGS + (((size_t)j * DB + bs) * NH + hh) * HD * HD; }
    return g;
}

__device__ __forceinline__ void p_mixer_naive(Frame& F, int L) {
    const bool gdn = L & 1;
    const int n_seq = gdn ? NB * NH + DB * NH : 0;
    const int n_fp = gdn ? 0 : NB * NH * (SEQ / 16);
    const int n_fs = gdn ? 0 : DB * NH;
    const int n_mp = NB * NMH * (SEQ / 16), n_ms = DB * NMH;
    const int total = n_seq + n_fp + n_fs + n_mp + n_ms;
    for (int u = F.bid; u < total; u += F.G) {
        int r = u;
        if (r < n_seq) { const NGdn g = mk_gdn(F, L, r); ngdn_unit(F, g); continue; }
        r -= n_seq;
        NAttn a;
        if (r < n_fp) { const int qt = (SEQ / 16 - 1) - r / (NB * NH), bh = r % (NB * NH); a = mk_fox_prompt(F, L, bh / NH, bh % NH, qt * 16, 16); }
        else if (r < n_fp + n_fs) { r -= n_fp; a = mk_fox_sample(F, L, r / NH, r % NH); }
        else if (r < n_fp + n_fs + n_mp) { r -= n_fp + n_fs; const int qt = r / (NB * NMH), bh = r % (NB * NMH); a = mk_mem_prompt(F, L, bh / NMH, bh % NMH, qt * 16, 16); }
        else { r -= n_fp + n_fs + n_mp; a = mk_mem_sample(F, L, r / NMH, r % NMH); }
        nattn_unit(F, a);
    }
}

__device__ __forceinline__ void p_gdn_naive(Frame& F, int L) {
    if (!(L & 1)) return;
    for (int u = F.bid; u < NB * NH + DB * NH; u += F.G) { const NGdn g = mk_gdn(F, L, u); ngdn_unit(F, g); }
}
#ifndef WGM_
#define WGM_ 4
#endif
namespace pg8 {
#define PG8_LAS __attribute__((address_space(3)))
constexpr int BM = 256, BK = 64, HALF = 128, HTB = HALF * BK * 2  , STAGE_BYTES = 8 * HTB, NXCD = 8, WGM = WGM_;

__host__ __device__ __forceinline__ int lds_byte(int r, int c) { const int st = (r >> 4) * 2 + (c >> 5), rr = r & 15, cc = c & 31, ob = rr * 64 + cc * 2; return st * 1024 + (ob ^ (((ob >> 9) & 1) << 5)); }
__host__ __device__ __forceinline__ void stage_rc(int b, int& R, int& C) { const int st = b / 1024, sb = b % 1024, swz = sb ^ (((sb >> 9) & 1) << 5); R = (st >> 1) * 16 + swz / 64; C = (st & 1) * 32 + (swz % 64) / 2; }
__host__ __device__ __forceinline__ int perm32(int rho) { const int n = rho >> 4, i = rho & 15; return 8 * (i >> 2) + 4 * n + (i & 3); }

struct Unit { int pm, pn, ks; };
struct Gemm { const bf16_t* A; const bf16_t* Bt; int M, N, K; };

struct StaticOrder {
    int nM, nN, nwg, G, c, wgm;
    __host__ __device__ void init(int M, int N, int G_, int c_, int wgm_ = WGM) { nM = M / BM; nN = N / BM; nwg = nM * nN; G = G_; c = c_; wgm = wgm_; }
    __host__ __device__ bool next(int i, Unit& u) const {
        const long L = (long)i * G + c; if (L >= nwg) return false;
        int wgid = (int)L; { const int q = nwg / NXCD, r = nwg % NXCD, xcd = wgid % NXCD, off = wgid / NXCD; wgid = (xcd < r ? xcd * (q + 1) : r * (q + 1) + (xcd - r) * q) + off; }
        const int nig = wgm * nN, gid = wgid / nig, fm = gid * wgm, gsz = (nM - fm) < wgm ? (nM - fm) : wgm;
        u.pm = fm + ((wgid % nig) % gsz); u.pn = (wgid % nig) / gsz; u.ks = -1; return true;
    }
    __device__ __forceinline__ void a_ready(const Unit&) const {}
    __device__ __forceinline__ void done(const Unit&) const {}
    __device__ __forceinline__ size_t koff(const Unit&) const { return 0; }
    __device__ __forceinline__ int nt(const Unit&, int ntf) const { return ntf; }
};

__device__ __forceinline__ unsigned cvt_pk_bf16(float lo, float hi) { unsigned r; asm volatile("v_cvt_pk_bf16_f32 %0, %1, %2" : "=v"(r) : "v"(lo), "v"(hi)); return r; }
template <class Epi, class Sched, bool ALIGN_EPI = false, bool SP2 = false>
__device__ __forceinline__ void gemm_phase(PG8_LAS unsigned char* lds, const Gemm g, const Sched& S, const Epi& E, int tid_in) {
    int tid_ = tid_in; asm volatile("" : "+v"(tid_));
    const int tid = tid_, wid = __builtin_amdgcn_readfirstlane(tid >> 6), lane = tid & 63, wr = wid >> 2, wc = wid & 3, fr = lane & 15, fq = lane >> 4;
    const int K = g.K, ntf = K / BK;
    unsigned voffA[2], voffB[2];
#pragma unroll
    for (int i = 0; i < 2; ++i) { int R, C; stage_rc(tid * 16 + i * 8192, R, C); const int Rb = Epi::PERM ? ((R & ~31) + perm32(R & 31)) : R;
        voffA[i] = (unsigned)(R * K + C) * 2u; voffB[i] = (unsigned)(Rb * K + C) * 2u; }
    const size_t kstep = (size_t)(BK * 2);
    const size_t hstep = (size_t)HALF * K * 2;
    const size_t tstep = 2 * hstep;
    const unsigned ldsw = (unsigned)wid * 1024u;
    const int aoff = lds_byte(wr * 64 + fr, fq * 8), boff = lds_byte(wc * 32 + fr, fq * 8);
#define PG8_SA(b, h) (((b) * 2 + (h)) * HTB)
#define PG8_SB(b, h) ((4 + (b) * 2 + (h)) * HTB)
#define PG8_STAGE(bufoff, gbase, voff) do { _Pragma("unroll") for (int _i = 0; _i < 2; ++_i) \
        __builtin_amdgcn_global_load_lds((const unsigned*)((const char*)(gbase) + (voff)[_i]), (PG8_LAS unsigned*)(lds + (bufoff) + ldsw + _i * 8192), 16, 0, 0); } while (0)
#define PG8_LDA(dst, b, h) do { _Pragma("unroll") for (int m = 0; m < 4; ++m) _Pragma("unroll") for (int k = 0; k < 2; ++k) dst[m][k] = *(const PG8_LAS bf16x8*)(lds + PG8_SA(b, h) + aoff + m * 2048 + k * 1024); } while (0)
#define PG8_LDB(dst, b, h) do { _Pragma("unroll") for (int n = 0; n < 2; ++n) _Pragma("unroll") for (int k = 0; k < 2; ++k) dst[n][k] = *(const PG8_LAS bf16x8*)(lds + PG8_SB(b, h) + boff + n * 2048 + k * 1024); } while (0)
#define PG8_MMA(ai, bj, At, Bt) do { __builtin_amdgcn_s_setprio(1); _Pragma("unroll") for (int m = 0; m < 4; ++m) _Pragma("unroll") for (int n = 0; n < 2; ++n) _Pragma("unroll") for (int k = 0; k < 2; ++k) \
        acc[ai][bj][m][n] = __builtin_amdgcn_mfma_f32_16x16x32_bf16(Bt[n][k], At[m][k], acc[ai][bj][m][n], 0, 0, 0); __builtin_amdgcn_s_setprio(0); } while (0)
#define PG8_WAIT_V(n) asm volatile("s_waitcnt vmcnt(" #n ")" ::: "memory")
#define PG8_WAIT_L(n) asm volatile("s_waitcnt lgkmcnt(" #n ")" ::: "memory")
#define PG8_BAR __builtin_amdgcn_s_barrier()
#define PG8_SCHED __builtin_amdgcn_sched_barrier(0)
    Unit cur, nxt; int ui = 0;
    if (!S.next(0, cur)) return;
    f32x4 acc[2][2][4][2];
#pragma unroll
    for (int a = 0; a < 2; ++a)
#pragma unroll
        for (int b = 0; b < 2; ++b)
#pragma unroll
            for (int m = 0; m < 4; ++m)
#pragma unroll
                for (int n = 0; n < 2; ++n) acc[a][b][m][n] = (f32x4){0.f, 0.f, 0.f, 0.f};
    bf16x8 At[4][2], B0[2][2], B1[2][2];
    const char* cA = (const char*)g.A + (size_t)cur.pm * tstep + S.koff(cur); const char* cB = (const char*)g.Bt + (size_t)cur.pn * tstep + S.koff(cur);
    int nt = S.nt(cur, ntf);
    S.a_ready(cur);
    if constexpr (SP2) {
        PG8_STAGE(PG8_SB(0, 0), cB, voffB); PG8_STAGE(PG8_SB(0, 1), cB + hstep, voffB); PG8_STAGE(PG8_SA(0, 0), cA, voffA); PG8_STAGE(PG8_SA(0, 1), cA + hstep, voffA);
        if (wr == 1) PG8_BAR;
        PG8_WAIT_V(2); PG8_BAR;
        PG8_STAGE(PG8_SB(1, 0), cB + kstep, voffB); PG8_STAGE(PG8_SA(1, 0), cA + kstep, voffA); PG8_STAGE(PG8_SB(1, 1), cB + hstep + kstep, voffB);
        PG8_WAIT_V(6); PG8_BAR;
    } else {
        PG8_STAGE(PG8_SB(0, 0), cB, voffB); PG8_STAGE(PG8_SA(0, 0), cA, voffA); PG8_STAGE(PG8_SB(0, 1), cB + hstep, voffB); PG8_STAGE(PG8_SA(0, 1), cA + hstep, voffA);
        if (wr == 1) PG8_BAR;
        PG8_WAIT_V(4); PG8_BAR;
        PG8_STAGE(PG8_SB(1, 0), cB + kstep, voffB); PG8_STAGE(PG8_SA(1, 0), cA + kstep, voffA); PG8_STAGE(PG8_SB(1, 1), cB + hstep + kstep, voffB);
        PG8_WAIT_V(6); PG8_BAR;
    }
    for (;;) {
        const bool has_next = S.next(ui + 1, nxt);
        const char* nA = has_next ? (const char*)g.A + (size_t)nxt.pm * tstep + S.koff(nxt) : cA; const char* nB = has_next ? (const char*)g.Bt + (size_t)nxt.pn * tstep + S.koff(nxt) : cB;
        for (int t = 0; t < nt; t += 2) {
            const bool last = (t == nt - 2);
            const char* a1 = cA + (size_t)(t + 1) * kstep;
            const char* a2 = last ? nA : cA + (size_t)(t + 2) * kstep; const char* b2 = last ? nB : cB + (size_t)(t + 2) * kstep;
            const char* a3 = a2 + kstep; const char* b3 = b2 + kstep;
            if (last && has_next) S.a_ready(nxt);
            if constexpr (SP2) {
            PG8_LDB(B0, 0, 0); PG8_LDB(B1, 0, 1); PG8_SCHED; PG8_LDA(At, 0, 0); PG8_STAGE(PG8_SA(1, 1), a1 + hstep, voffA);
            PG8_WAIT_V(8); PG8_WAIT_L(0); PG8_BAR; PG8_MMA(0, 0, At, B0); PG8_MMA(0, 1, At, B1); PG8_BAR; PG8_SCHED;
            PG8_LDA(At, 0, 1); PG8_STAGE(PG8_SB(0, 0), b2, voffB); PG8_STAGE(PG8_SB(0, 1), b2 + hstep, voffB); PG8_STAGE(PG8_SA(0, 0), a2, voffA);
            PG8_WAIT_V(8); PG8_WAIT_L(0); PG8_BAR; PG8_MMA(1, 0, At, B0); PG8_MMA(1, 1, At, B1); PG8_BAR; PG8_SCHED;
            PG8_LDB(B0, 1, 0); PG8_LDB(B1, 1, 1); PG8_SCHED; PG8_LDA(At, 1, 0); PG8_STAGE(PG8_SA(0, 1), a2 + hstep, voffA);
            PG8_WAIT_V(8); PG8_WAIT_L(0); PG8_BAR; PG8_MMA(0, 0, At, B0); PG8_MMA(0, 1, At, B1); PG8_BAR; PG8_SCHED;
            PG8_LDA(At, 1, 1); PG8_STAGE(PG8_SB(1, 0), b3, voffB); PG8_STAGE(PG8_SB(1, 1), b3 + hstep, voffB); PG8_STAGE(PG8_SA(1, 0), a3, voffA);
            PG8_WAIT_V(8); PG8_WAIT_L(0); PG8_BAR; PG8_MMA(1, 0, At, B0); PG8_MMA(1, 1, At, B1); PG8_BAR; PG8_SCHED;
            } else {
            PG8_LDB(B0, 0, 0); PG8_SCHED; PG8_LDA(At, 0, 0); PG8_STAGE(PG8_SA(1, 1), a1 + hstep, voffA);
            PG8_WAIT_L(8); PG8_BAR; PG8_WAIT_L(0); PG8_MMA(0, 0, At, B0); PG8_BAR; PG8_SCHED;
            PG8_LDB(B1, 0, 1); PG8_STAGE(PG8_SB(0, 0), b2, voffB);
            PG8_BAR; PG8_WAIT_L(0); PG8_MMA(0, 1, At, B1); PG8_BAR;
            PG8_LDA(At, 0, 1); PG8_STAGE(PG8_SA(0, 0), a2, voffA);
            PG8_BAR; PG8_WAIT_L(0); PG8_MMA(1, 0, At, B0); PG8_BAR; PG8_SCHED;
            PG8_STAGE(PG8_SB(0, 1), b2 + hstep, voffB);
            PG8_WAIT_V(6); PG8_BAR; PG8_MMA(1, 1, At, B1); PG8_BAR;
            PG8_LDB(B0, 1, 0); PG8_SCHED; PG8_LDA(At, 1, 0); PG8_STAGE(PG8_SA(0, 1), a2 + hstep, voffA);
            PG8_WAIT_L(8); PG8_BAR; PG8_WAIT_L(0); PG8_MMA(0, 0, At, B0); PG8_BAR; PG8_SCHED;
            PG8_LDB(B1, 1, 1); PG8_STAGE(PG8_SB(1, 0), b3, voffB);
            PG8_BAR; PG8_WAIT_L(0); PG8_MMA(0, 1, At, B1); PG8_BAR;
            PG8_LDA(At, 1, 1); PG8_STAGE(PG8_SA(1, 0), a3, voffA);
            PG8_BAR; PG8_WAIT_L(0); PG8_MMA(1, 0, At, B0); PG8_BAR; PG8_SCHED;
            PG8_STAGE(PG8_SB(1, 1), b3 + hstep, voffB);
            PG8_WAIT_V(6); PG8_BAR; PG8_MMA(1, 1, At, B1); PG8_BAR;
            }
        }
        if constexpr (ALIGN_EPI) { if (wr == 0) PG8_BAR; }
        if constexpr (!Epi::AFTER_DRAIN) { int l2_ = tid & 63; asm volatile("" : "+v"(l2_)); E(acc, cur, wr, wc, l2_ & 15, l2_ >> 4); S.done(cur); }
        if (!has_next) break;
#pragma unroll
        for (int a = 0; a < 2; ++a)
#pragma unroll
            for (int b = 0; b < 2; ++b)
#pragma unroll
                for (int m = 0; m < 4; ++m)
#pragma unroll
                    for (int n = 0; n < 2; ++n) acc[a][b][m][n] = (f32x4){0.f, 0.f, 0.f, 0.f};
        cur = nxt; cA = nA; cB = nB; ++ui; nt = S.nt(cur, ntf);
        if constexpr (ALIGN_EPI) { if (wr == 1) PG8_BAR; }
    }
    PG8_WAIT_V(0);
    if constexpr (!ALIGN_EPI) { if (wr == 0) PG8_BAR; }
    PG8_BAR;
    if constexpr (Epi::AFTER_DRAIN) { E.fused(acc, cur, wr, wc, fr, fq, lds, wid, lane); S.done(cur); }
#undef PG8_SA
#undef PG8_SB
#undef PG8_STAGE
#undef PG8_LDA
#undef PG8_LDB
#undef PG8_MMA
#undef PG8_WAIT_V
#undef PG8_WAIT_L
#undef PG8_BAR
#undef PG8_SCHED
}
}
__device__ __forceinline__ u32x4 pack8_bf16(f32x4 a, f32x4 b) {
    u32x4 w; w.x = pg8::cvt_pk_bf16(a[0], a[1]); w.y = pg8::cvt_pk_bf16(a[2], a[3]); w.z = pg8::cvt_pk_bf16(b[0], b[1]); w.w = pg8::cvt_pk_bf16(b[2], b[3]); return w;
}
struct EpiInProjV {
    static constexpr bool PERM = true, AFTER_DRAIN = false;
    int L; float* out; unsigned char* ws; const float* bfor; const float* alog; const float* dtb;
#define EPI_FOR_GROUPS(...) _Pragma("unroll") for (int ai = 0; ai < 2; ++ai) { _Pragma("unroll") for (int m = 0; m < 4; ++m) { const int r = row0 + ai * 128 + m * 16; \
        _Pragma("unroll") for (int bj = 0; bj < 2; ++bj) { const f32x4 v0 = acc[ai][bj][m][0], v1 = acc[ai][bj][m][1]; __VA_ARGS__ } asm volatile("" ::: "memory"); } }
    __device__ __forceinline__ void operator()(const f32x4 (&acc)[2][2][4][2], const pg8::Unit& u, int wr, int wc, int fr_, int fq_) const {
        int fr = fr_, fq = fq_; asm volatile("" : "+v"(fr), "+v"(fq));
        const int j = L >> 1; const bool gdn = (L & 1) != 0; const int pn = u.pn, pm = u.pm;
        bf16_t* qkv = (bf16_t*)(ws + WS_QKV); bf16_t* qm = (bf16_t*)(ws + WS_QM); bf16_t* zs = (bf16_t*)(ws + WS_ZS); float* ga = (float*)(ws + WS_GA); float* beta = (float*)(ws + WS_BETA);
        const int row0 = pm * 256 + wr * 64 + fr, cl = wc * 32 + 8 * fq;
        if (pn < 18) {
            bf16_t* qb = qkv + pn * 256 + cl;
            if (gdn || pn < 18) { EPI_FOR_GROUPS( *(u32x4*)(qb + (size_t)r * CONVCH + bj * 128) = pack8_bf16(v0, v1); ) }
            if (!gdn) {
                if (pn >= 6) {
                    const bool isv = pn >= 12; const int cc = pn * 256 + cl - (isv ? 2 * MIXW : MIXW);
                    float* ob = (pm < 64 ? out + (isv ? O_PFV : O_PFK) + (size_t)j * MP * MIXW : out + (isv ? O_SFV : O_SFK) + ((size_t)j * MS - MP) * MIXW) + cc;
                    EPI_FOR_GROUPS( float* o = ob + (size_t)r * MIXW + bj * 128; *(f32x4*)o = v0; *(f32x4*)(o + 4) = v1; )
                }
            } else if (pm == 31 || pm >= 63) {
                const int c0b = pn * 256 + cl;
                EPI_FOR_GROUPS( float* o = nullptr;
                    if (r < MP) { const int t = r & (SEQ - 1), b = r >> 13; if (t >= SEQ - 3) o = out + O_PGC + (((size_t)j * NB + b) * 3 + (t - (SEQ - 3))) * CONVCH + c0b + bj * 128; }
                    else { const int s = r - MP, l = s & 15, bs = s >> 4; if (l >= DS - 3) o = out + O_SGC + (((size_t)j * DB + bs) * 3 + (l - (DS - 3))) * CONVCH + c0b + bj * 128; }
                    if (o) { *(f32x4*)o = v0; *(f32x4*)(o + 4) = v1; } )
            }
        } else if (pn < 20) {
            bf16_t* qb = qm + (pn * 256 + cl - C_QM);
            EPI_FOR_GROUPS( *(u32x4*)(qb + (size_t)r * MEMW + bj * 128) = pack8_bf16(v0, v1); )
        } else if (pn < 28) {
            bf16_t* zb = zs + (pn * 256 + cl - C_Z);
            EPI_FOR_GROUPS( f32x4 s0; f32x4 s1;
                _Pragma("unroll") for (int e = 0; e < 4; ++e) { s0[e] = siluf(v0[e]); s1[e] = siluf(v1[e]); }
                *(u32x4*)(zb + (size_t)r * BRW + bj * 128) = pack8_bf16(s0, s1); )
        } else if (cl < 2 * NH) {
            EPI_FOR_GROUPS( if (bj == 0) {
                _Pragma("unroll") for (int e = 0; e < 8; ++e) { const int c = cl + e; const float v = e < 4 ? v0[e & 3] : v1[e & 3];
                    if (!gdn) {
                        if (c < NH) { const float lf = logsigmoidf(v + bfor[j * NH + c]);
                            if (r < MP) out[O_PFL + ((size_t)j * MP + r) * NH + c] = lf; else out[O_SFL + ((size_t)j * MS + (r - MP)) * NH + c] = lf; }
                    } else {
                        if (c < NH) ga[(size_t)r * NH + c] = -__expf(alog[j * NH + c]) * softplusf(v + dtb[j * NH + c]);
                        else if (c < 2 * NH) beta[(size_t)r * NH + (c - NH)] = sigmoidf_(v);
                    } } } )
        }
    }
#undef EPI_FOR_GROUPS
};
__device__ __forceinline__ EpiInProjV mk_epi_inproj_v(const Frame& F, int L) {
    EpiInProjV e; e.L = L; e.out = F.out(); e.ws = F.ws(); e.bfor = F.in(14); e.alog = F.in(17); e.dtb = F.in(18); return e;
}
struct EpiOutProjV {
    static constexpr bool PERM = true, AFTER_DRAIN = false;
    int L; float* out; const float* xp; const float* xs; float* part;
    __device__ __forceinline__ void operator()(const f32x4 (&acc)[2][2][4][2], const pg8::Unit& u, int wr, int wc, int fr_, int fq_) const {
        int fr = fr_, fq = fq_; asm volatile("" : "+v"(fr), "+v"(fq));
        const int row0 = u.pm * 256 + wr * 64 + fr, cl = u.pn * 256 + wc * 32 + 8 * fq;
        if (u.ks < 0) {
#pragma unroll
            for (int ai = 0; ai < 2; ++ai) {
                f32x4 xo[4][2][2];
#pragma unroll
                for (int m = 0; m < 4; ++m) { const int r = row0 + ai * 128 + m * 16;
                    const float* xp_ = L == 0 ? (r < MP ? xp + (size_t)r * DM : xs + (size_t)(r - MP) * DM) : out + (size_t)r * DM;
#pragma unroll
                    for (int bj = 0; bj < 2; ++bj) { xo[m][bj][0] = *(const f32x4*)(xp_ + cl + bj * 128); xo[m][bj][1] = *(const f32x4*)(xp_ + cl + bj * 128 + 4); } }
                asm volatile("" ::: "memory");
#pragma unroll
                for (int m = 0; m < 4; ++m) { float* xn = out + (size_t)(row0 + ai * 128 + m * 16) * DM;
#pragma unroll
                    for (int bj = 0; bj < 2; ++bj) { *(f32x4*)(xn + cl + bj * 128) = xo[m][bj][0] + acc[ai][bj][m][0]; *(f32x4*)(xn + cl + bj * 128 + 4) = xo[m][bj][1] + acc[ai][bj][m][1]; } }
                asm volatile("" ::: "memory");
            }
        } else {
            const int rl0 = row0 - MP + u.ks * MS;
#pragma unroll
            for (int ai = 0; ai < 2; ++ai)
#pragma unroll
                for (int m = 0; m < 4; ++m) {
                    float* xn = part + (size_t)(rl0 + ai * 128 + m * 16) * DM;
#pragma unroll
                    for (int bj = 0; bj < 2; ++bj) { const int c0 = cl + bj * 128; *(f32x4*)(xn + c0) = acc[ai][bj][m][0]; *(f32x4*)(xn + c0 + 4) = acc[ai][bj][m][1]; }
                }
        }
    }
};
struct EpiMemKVV {
    static constexpr bool PERM = true, AFTER_DRAIN = false;
    float* out;
    __device__ __forceinline__ void operator()(const f32x4 (&acc)[2][2][4][2], const pg8::Unit& u, int wr, int wc, int fr_, int fq_) const {
        int fr = fr_, fq = fq_; asm volatile("" : "+v"(fr), "+v"(fq));
        const int L = u.pm >> 1, row0 = (u.pm & 1) * 256 + wr * 64 + fr, cl = (u.pn & 3) * 256 + wc * 32 + 8 * fq;
#pragma unroll
        for (int ai = 0; ai < 2; ++ai)
#pragma unroll
            for (int m = 0; m < 4; ++m) {
                const int r = row0 + ai * 128 + m * 16;
#pragma unroll
                for (int bj = 0; bj < 2; ++bj) { const int c0 = cl + bj * 128;
                    float* o = c0 < MEMW ? out + O_PMK + ((size_t)L * 512 + r) * MEMW + c0 : out + O_PMV + ((size_t)L * 512 + r) * MEMW + (c0 - MEMW);
                    *(f32x4*)o = acc[ai][bj][m][0]; *(f32x4*)(o + 4) = acc[ai][bj][m][1]; }
            }
    }
};
struct MemKvOrder {
    int G, c;
    __device__ __forceinline__ bool next(int i, pg8::Unit& u) const {
        const int idx = i * G + c; if (idx >= 32) return false;
        const int L = idx >> 3, rem = idx & 7; u.pm = 2 * L + (rem >> 2); u.pn = 4 * L + (rem & 3); u.ks = -1; return true;
    }
    __device__ __forceinline__ void a_ready(const pg8::Unit&) const {}
    __device__ __forceinline__ void done(const pg8::Unit&) const {}
    __device__ __forceinline__ size_t koff(const pg8::Unit&) const { return 0; }
    __device__ __forceinline__ int nt(const pg8::Unit&, int ntf) const { return ntf; }
};
#ifndef OP_SPLIT
#define OP_SPLIT 0
#endif
#ifndef OP_WGM
#define OP_WGM 4
#endif
struct OutProjOrder {
    pg8::StaticOrder P; int G, c;
    __device__ __forceinline__ void init(int G_, int c_) { P.init(OP_SPLIT ? MP : MR, DM, G_, c_, OP_WGM); G = G_; c = c_; }
    __device__ __forceinline__ bool next(int i, pg8::Unit& u) const {
        if (!OP_SPLIT) return P.next(i, u);
        const int idx = i * G + c; if (idx < 512) return P.next(i, u);
        const int sub = idx - 512; if (sub >= 16 * OP_KS) return false;
        const int tile = sub / OP_KS; u.pm = 64 + (tile >> 3); u.pn = tile & 7; u.ks = sub % OP_KS; return true;
    }
    __device__ __forceinline__ void a_ready(const pg8::Unit&) const {}
    __device__ __forceinline__ void done(const pg8::Unit&) const {}
    __device__ __forceinline__ size_t koff(const pg8::Unit& u) const { return u.ks < 0 ? 0 : (size_t)u.ks * (BRW / OP_KS) * 2; }
    __device__ __forceinline__ int nt(const pg8::Unit& u, int ntf) const { return u.ks < 0 ? ntf : ntf / OP_KS; }
};
namespace att {
constexpr int NW = 8, QBLK = 32, KVBLK = 64, QB = NW * QBLK, D = 128;
constexpr int SHM_V = KVBLK * D * 2, SHM_K = KVBLK * D * 2;
constexpr int OFF_V = 0, OFF_K = 2 * SHM_V, OFF_WS = 2 * SHM_V + 2 * SHM_K, OFF_G = OFF_WS + NW * 64 * 4, OFF_Q = OFF_G + 8192 * 4, LDS_BYTES = OFF_Q + 64;
constexpr float SCALE = 0.08838834764831845f, LOG2E = 1.4426950408889634f, C2 = LOG2E * SCALE, THR2 = 8.f * LOG2E;
constexpr unsigned WINF = 0x7fffffffu;

#define KSWZ(row, colB) ((row) * 256 + ((colB) ^ (((row) & 7) << 4)))
#define SBAR() __builtin_amdgcn_sched_barrier(0)
__device__ __forceinline__ int v_st(int k, int c) { const int kk = (k & ~0xC) | ((k & 4) << 1) | ((k & 8) >> 1); return ((kk >> 3) * 4 + (c >> 5)) * 512 + ((kk & 7) * 32 + (c & 31)) * 2; }
__device__ __forceinline__ int v_rd_base(int lane) { return ((lane & 3) << 3) | (((lane >> 2) & 3) << 6) | (((lane >> 4) & 1) << 5) | (((lane >> 5) & 1) << 8); }
constexpr int v_rd_off(int d0, int ks, int half) { return d0 * 512 + ks * 4096 + half * 2048; }
__device__ __forceinline__ int crow(int r, int hi) { return (r & 3) + 8 * (r >> 2) + 4 * hi; }
__device__ __forceinline__ unsigned cvtpk(float lo, float hi) { unsigned r; asm volatile("v_cvt_pk_bf16_f32 %0, %1, %2" : "=v"(r) : "v"(lo), "v"(hi)); return r; }
__device__ __forceinline__ bf16x8 pack8(f32x4 a, f32x4 b) { u32x4 w = {cvtpk(a[0], a[1]), cvtpk(a[2], a[3]), cvtpk(b[0], b[1]), cvtpk(b[2], b[3])}; return __builtin_bit_cast(bf16x8, w); }

__device__ __forceinline__ void mask_tile(f32x16& p0, f32x16& p1, int dq, unsigned W) {
    const float NEG = -__builtin_inff();
#pragma unroll
    for (int r = 0; r < 16; ++r) { const int c = (r & 3) + 8 * (r >> 2);
        if ((unsigned)(dq - c) >= W) p0[r] = NEG;
        if ((unsigned)(dq - c - 32) >= W) p1[r] = NEG; }
}
__device__ __forceinline__ void partialSM(f32x16& p0, f32x16& p1, const LAS float* gl, int hi, float& m_reg, float& mn, float& alpha) {
#pragma unroll
    for (int g = 0; g < 4; ++g) { const f32x4 b0 = *(const LAS f32x4*)(gl + 8 * g + 4 * hi), b1 = *(const LAS f32x4*)(gl + 32 + 8 * g + 4 * hi);
#pragma unroll
        for (int e = 0; e < 4; ++e) { p0[4 * g + e] = fmaf(p0[4 * g + e], C2, b0[e]); p1[4 * g + e] = fmaf(p1[4 * g + e], C2, b1[e]); } }
    float pmax = p0[0];
#pragma unroll
    for (int r = 1; r < 16; ++r) pmax = fmaxf(pmax, p0[r]);
#pragma unroll
    for (int r = 0; r < 16; ++r) pmax = fmaxf(pmax, p1[r]);
    { auto rr = __builtin_amdgcn_permlane32_swap(__float_as_uint(pmax), __float_as_uint(pmax), false, false);
      pmax = fmaxf(__uint_as_float(rr[0]), __uint_as_float(rr[1])); }
    if (__builtin_expect(__all((pmax - m_reg) <= THR2), 1)) { mn = m_reg; alpha = 1.f; }
    else { mn = fmaxf(m_reg, pmax); alpha = __builtin_amdgcn_exp2f(m_reg - mn); m_reg = mn; }
#pragma unroll
    for (int r = 0; r < 16; ++r) { p0[r] = __builtin_amdgcn_exp2f(p0[r] - mn); p1[r] = p1[r] - mn; }
}
__device__ __forceinline__ void finishSM(f32x16& p0, f32x16& p1, float alpha, float& l_reg, bf16x8& pa0, bf16x8& pa1, bf16x8& pa2, bf16x8& pa3) {
#pragma unroll
    for (int r = 0; r < 16; ++r) p1[r] = __builtin_amdgcn_exp2f(p1[r]);
    float ps = 0;
#pragma unroll
    for (int r = 0; r < 16; ++r) ps += p0[r];
#pragma unroll
    for (int r = 0; r < 16; ++r) ps += p1[r];
    { auto rr = __builtin_amdgcn_permlane32_swap(__float_as_uint(ps), __float_as_uint(ps), false, false);
      ps = __uint_as_float(rr[0]) + __uint_as_float(rr[1]); }
    l_reg = l_reg * alpha + ps;
#define PK4(P, B_, OUT) do { unsigned a0 = cvtpk(P[B_+0], P[B_+1]), a1 = cvtpk(P[B_+2], P[B_+3]);                          \
        unsigned b0 = cvtpk(P[B_+4], P[B_+5]), b1 = cvtpk(P[B_+6], P[B_+7]);                                             \
        auto r0 = __builtin_amdgcn_permlane32_swap(a0, b0, false, false); auto r1 = __builtin_amdgcn_permlane32_swap(a1, b1, false, false); \
        u32x4 w = {r0[0], r1[0], r0[1], r1[1]}; OUT = __builtin_bit_cast(bf16x8, w); } while (0)
    PK4(p0, 0, pa0); PK4(p0, 8, pa1); PK4(p1, 0, pa2); PK4(p1, 8, pa3);
#undef PK4
}
template <int KB>
__device__ __forceinline__ void qkt(f32x16& p0, f32x16& p1, const LAS char* K_lds, int r32, int hi, const bf16x8* qr) {
    p0 = f32x16{}; p1 = f32x16{};
    const LAS char* kb[4];
#pragma unroll
    for (int dd = 0; dd < 4; ++dd) kb[dd] = K_lds + KB * SHM_K + KSWZ(r32, (dd * 16 + hi * 8) * 2);
#pragma unroll
    for (int d0 = 0; d0 < 8; ++d0) { const LAS char* a = kb[d0 & 3] + (d0 >> 2) * 128;
        const bf16x8 b0 = *(const LAS bf16x8*)(a);
        const bf16x8 b1 = *(const LAS bf16x8*)(a + 32 * 256);
        p0 = __builtin_amdgcn_mfma_f32_32x32x16_bf16(b0, qr[d0], p0, 0, 0, 0);
        p1 = __builtin_amdgcn_mfma_f32_32x32x16_bf16(b1, qr[d0], p1, 0, 0, 0); }
}
template <int VB>
__device__ __forceinline__ void pv_tile(f32x16* o, int vb0, bf16x8 pa0, bf16x8 pa1, bf16x8 pa2, bf16x8 pa3) {
#define TRRD(dst, off) asm volatile("ds_read_b64_tr_b16 %0, %1 offset:%2" : "=&v"(dst) : "v"(vb0), "i"(off) : "memory")
#define PV_D0(d0) do { s16x4 l0, l1, l2, l3, h0, h1, h2, h3; constexpr int b_ = VB * SHM_V + v_rd_off(d0, 0, 0); \
        TRRD(l0, b_); TRRD(h0, b_ + 2048); TRRD(l1, b_ + 4096); TRRD(h1, b_ + 6144); TRRD(l2, b_ + 8192); TRRD(h2, b_ + 10240); TRRD(l3, b_ + 12288); TRRD(h3, b_ + 14336); \
        asm volatile("s_waitcnt lgkmcnt(0)" ::: "memory"); SBAR(); \
        o[d0] = __builtin_amdgcn_mfma_f32_32x32x16_bf16(pa0, (bf16x8){l0[0], l0[1], l0[2], l0[3], h0[0], h0[1], h0[2], h0[3]}, o[d0], 0, 0, 0);   \
        o[d0] = __builtin_amdgcn_mfma_f32_32x32x16_bf16(pa1, (bf16x8){l1[0], l1[1], l1[2], l1[3], h1[0], h1[1], h1[2], h1[3]}, o[d0], 0, 0, 0);   \
        o[d0] = __builtin_amdgcn_mfma_f32_32x32x16_bf16(pa2, (bf16x8){l2[0], l2[1], l2[2], l2[3], h2[0], h2[1], h2[2], h2[3]}, o[d0], 0, 0, 0);   \
        o[d0] = __builtin_amdgcn_mfma_f32_32x32x16_bf16(pa3, (bf16x8){l3[0], l3[1], l3[2], l3[3], h3[0], h3[1], h3[2], h3[3]}, o[d0], 0, 0, 0); } while (0)
    PV_D0(0); PV_D0(1); PV_D0(2); PV_D0(3);
#undef PV_D0
#undef TRRD
}

struct Ref {
    const bf16_t* Q; const float* K1; const float* V1; const float* K2; const float* V2; const float* G; bf16_t* O;
    int q_stride, kv_stride;
    int kvb16;
    int jsw;
    int P0;
    int skv;
    int nvalid;
    float gref;
};
struct Next { const bf16_t* Q; const float* K1; const float* V1; int q_stride, kv_stride, nvalid, kvb16; };
__device__ __forceinline__ Next next_of(const Ref& r) { Next n; n.Q = r.Q; n.K1 = r.K1; n.V1 = r.V1; n.q_stride = r.q_stride; n.kv_stride = r.kv_stride; n.nvalid = r.nvalid; n.kvb16 = r.kvb16; return n; }
struct Seam { bf16x8 qr[8]; f32x4 sf0, sf1, sf2, sf3; };

#define VMW() asm volatile("s_waitcnt vmcnt(0)" ::: "memory")
#define VMWN(n) asm volatile("s_waitcnt vmcnt(%0)" :: "i"(n) : "memory")
#define A_TID(v_) int v_ = tid; asm volatile("" : "+v"(v_))
#define A_KOFF(str_, b16_) A_TID(t2_); const int esh_ = (b16_) ? 1 : 2; const unsigned koff0 = ((unsigned)(t2_ >> 4) * (unsigned)(str_) + (unsigned)((t2_ & 15) * 8)) << esh_, koff1 = koff0 + ((32u * (unsigned)(str_)) << esh_)
#define A_LD4(p_) do { if (b16q_) { S.sf0 = *(const f32x4*)(p_ + koff0); S.sf2 = *(const f32x4*)(p_ + koff1); } \
        else { S.sf0 = *(const f32x4*)(p_ + koff0); S.sf1 = *(const f32x4*)(p_ + koff0 + 16); S.sf2 = *(const f32x4*)(p_ + koff1); S.sf3 = *(const f32x4*)(p_ + koff1 + 16); } } while (0)
#define A_SLOAD(R_, WHICH, t_) do { constexpr bool b16q_ = B16; A_KOFF((R_).kv_stride, b16q_); \
        const char* p_ = (const char*)(((t_) < (R_).jsw) ? (R_).WHICH##1 : (R_).WHICH##2) + (((size_t)((t_) * KVBLK) * (size_t)(R_).kv_stride) << esh_); A_LD4(p_); } while (0)
#define A_SLOADN(N_, WHICH) do { constexpr bool b16q_ = B16; A_KOFF((N_).kv_stride, b16q_); const char* p_ = (const char*)(N_).WHICH; A_LD4(p_); } while (0)
#define A_SLOADH(R_, t_) do { A_KOFF((R_).kv_stride, true); const size_t tb_ = ((size_t)((t_) * KVBLK) * (size_t)(R_).kv_stride) << 1; const char* pk_ = (const char*)(R_).K1 + tb_; const char* pv_ = (const char*)(R_).V1 + tb_; \
        S.sf0 = *(const f32x4*)(pk_ + koff0); S.sf2 = *(const f32x4*)(pk_ + koff1); S.sf1 = *(const f32x4*)(pv_ + koff0); S.sf3 = *(const f32x4*)(pv_ + koff1); } while (0)
#define A_SWRITE_KH(bf) do { A_TID(t3_); const int sr_ = t3_ >> 4, kws = KSWZ(sr_, (t3_ & 15) * 16); *(LAS bf16x8*)(K_lds + (bf) * SHM_K + kws) = __builtin_bit_cast(bf16x8, S.sf0); *(LAS bf16x8*)(K_lds + (bf) * SHM_K + kws + 32 * 256) = __builtin_bit_cast(bf16x8, S.sf2); } while (0)
#define A_SWRITE_VH(bf) do { A_TID(t4_); const int sr_ = t4_ >> 4, sc_ = (t4_ & 15) * 8, vst0 = v_st(sr_, sc_), vst1 = v_st(32 + sr_, sc_); *(LAS bf16x8*)(V_lds + (bf) * SHM_V + vst0) = __builtin_bit_cast(bf16x8, S.sf1); *(LAS bf16x8*)(V_lds + (bf) * SHM_V + vst1) = __builtin_bit_cast(bf16x8, S.sf3); } while (0)
#define A_PK(lo_, hi_, b16_) ((b16_) ? __builtin_bit_cast(bf16x8, lo_) : pack8(lo_, hi_))
#define A_SWRITE_K(bf, b16_) do { A_TID(t3_); const int sr_ = t3_ >> 4, kws = KSWZ(sr_, (t3_ & 15) * 16); *(LAS bf16x8*)(K_lds + (bf) * SHM_K + kws) = A_PK(S.sf0, S.sf1, b16_); *(LAS bf16x8*)(K_lds + (bf) * SHM_K + kws + 32 * 256) = A_PK(S.sf2, S.sf3, b16_); } while (0)
#define A_SWRITE_V(bf, b16_) do { A_TID(t4_); const int sr_ = t4_ >> 4, sc_ = (t4_ & 15) * 8, vst0 = v_st(sr_, sc_), vst1 = v_st(32 + sr_, sc_); *(LAS bf16x8*)(V_lds + (bf) * SHM_V + vst0) = A_PK(S.sf0, S.sf1, b16_); *(LAS bf16x8*)(V_lds + (bf) * SHM_V + vst1) = A_PK(S.sf2, S.sf3, b16_); } while (0)

template <bool B16>
__device__ __forceinline__ void attn_prime(const Ref& cur, LAS char* lds, Seam& S, int tid) {
    const int wid = __builtin_amdgcn_readfirstlane(tid >> 6), lane = tid & 63, r32 = lane & 31, hi = lane >> 5;
    LAS char* K_lds = lds + OFF_K;
    int qrow = wid * QBLK + r32; qrow = qrow < cur.nvalid ? qrow : cur.nvalid - 1;
#pragma unroll
    for (int d0 = 0; d0 < 8; ++d0) S.qr[d0] = *(const bf16x8*)(cur.Q + (size_t)qrow * cur.q_stride + d0 * 16 + hi * 8);
    if constexpr (B16) { A_SLOADH(cur, 0); VMW(); A_SWRITE_KH(0); }
    else { A_SLOAD(cur, K, 0); VMW(); A_SWRITE_K(0, B16); SBAR(); A_SLOAD(cur, V, 0); }
    __syncthreads();
}
template <bool B16>
__device__ __forceinline__ void attn_block(const Ref& cur, const Next& nxt, LAS char* lds, Seam& S, int tid) {
    const int wid = __builtin_amdgcn_readfirstlane(tid >> 6), lane = tid & 63, r32 = lane & 31, hi = lane >> 5;
    int j_hi = (cur.P0 + QB - 1) / KVBLK + 1; if (j_hi > cur.skv / KVBLK) j_hi = cur.skv / KVBLK;
    const int NT = j_hi;
    const bool act = wid * QBLK < cur.nvalid;
    const int qlo = cur.P0 + wid * QBLK, qm = qlo + r32 - 4 * hi;
    LAS char* V_lds = lds + OFF_V; LAS char* K_lds = lds + OFF_K; LAS float* G_lds = (LAS float*)(lds + OFF_G);
    LAS float* ws = (LAS float*)(lds + OFF_WS) + wid * 64; LAS float* li_l = ws; LAS float* al_l = ws + 32;
    float m_reg = -1e30f, l_reg = 0; f32x16 o[4] = {};
    const int vb0 = (int)(unsigned)(size_t)V_lds + v_rd_base(lane);
#define RESC(a) do { if (__any((a) < 1.f)) { if (hi == 0) al_l[r32] = (a); asm volatile("s_waitcnt lgkmcnt(0)" ::: "memory");              \
                     _Pragma("unroll") for (int d_ = 0; d_ < 4; ++d_) { _Pragma("unroll") for (int r = 0; r < 16; ++r) o[d_][r] *= al_l[crow(r, hi)]; } } } while (0)
#define MASKT(P0_, P1_, t) do { const int kb_ = (t) * KVBLK; if (kb_ + KVBLK - 1 > qlo) mask_tile(P0_, P1_, qm - kb_, WINF); } while (0)
    f32x16 pA0, pA1, pB0, pB1; float mnA, mnB, alA, alB; bf16x8 pa0, pa1, pa2, pa3;
    { A_TID(t5_); for (int i = t5_ * 4; i < NT * KVBLK; i += 2048) { const f32x4 g = *(const f32x4*)((const char*)cur.G + (unsigned)i * 4u); *(LAS f32x4*)(G_lds + i) = (cur.gref - g) * LOG2E; } }
    constexpr bool cb16 = B16;
    if constexpr (B16) {
        A_SWRITE_VH(0); SBAR(); __syncthreads();
        if (NT > 1) { A_SLOADH(cur, 1); }
        SBAR(); if (act) qkt<0>(pA0, pA1, K_lds, r32, hi, S.qr);
        if (act) { MASKT(pA0, pA1, 0); partialSM(pA0, pA1, G_lds, hi, m_reg, mnA, alA); }
        if (NT > 1) { VMW(); A_SWRITE_KH(1); A_SWRITE_VH(1); }
    } else {
    VMW(); A_SWRITE_V(0, cb16); SBAR(); __syncthreads();
    if (NT > 1) { A_SLOAD(cur, K, 1); }
    SBAR(); if (act) qkt<0>(pA0, pA1, K_lds, r32, hi, S.qr);
    if (NT > 1) { VMW(); A_SWRITE_K(1, cb16); SBAR(); A_SLOAD(cur, V, 1); }
    if (act) { MASKT(pA0, pA1, 0); partialSM(pA0, pA1, G_lds, hi, m_reg, mnA, alA); }
    if (NT > 1) { VMW(); A_SWRITE_V(1, cb16); SBAR(); if (NT > 2) { A_SLOAD(cur, K, 2); } }
    }
    __syncthreads();
#define HALF_STEP(PX0, PX1, mnX, alX, PY0, PY1, alY, t, KB, VB, SB) do {                                                      \
        SBAR(); if (act) { qkt<KB>(PX0, PX1, K_lds, r32, hi, S.qr);                                                           \
        finishSM(PY0, PY1, alY, l_reg, pa0, pa1, pa2, pa3); } SBAR();                                                           \
        if ((t) + 1 < NT) { if constexpr (B16) { A_SLOADH(cur, (t) + 1); SBAR(); } else { VMW(); A_SWRITE_K(SB, cb16); SBAR(); A_SLOAD(cur, V, (t) + 1); SBAR(); } }       \
        if (act) { pv_tile<VB>(o, vb0, pa0, pa1, pa2, pa3); MASKT(PX0, PX1, (t)); partialSM(PX0, PX1, G_lds + (t) * 64, hi, m_reg, mnX, alX); } \
        __syncthreads();                                                                                                      \
        if ((t) + 1 < NT) { if constexpr (B16) { VMW(); A_SWRITE_KH(SB); A_SWRITE_VH(SB); } else { VMW(); A_SWRITE_V(SB, cb16); SBAR(); if ((t) + 2 < NT) { A_SLOAD(cur, K, (t) + 2); } } } \
        if (act) RESC(alX); __syncthreads(); } while (0)
    for (int t = 1; t + 1 < NT; t += 2) {
        HALF_STEP(pB0, pB1, mnB, alB, pA0, pA1, alA, t, 1, 0, 0);
        HALF_STEP(pA0, pA1, mnA, alA, pB0, pB1, alB, t + 1, 0, 1, 1);
    }
    const bool even = (NT & 1) == 0;
    if (even && act) { SBAR(); qkt<1>(pB0, pB1, K_lds, r32, hi, S.qr); SBAR(); }
    { if constexpr (B16) { A_SLOADH(nxt, 0); } else { A_SLOADN(nxt, K1); } SBAR();
      int qrow = wid * QBLK + r32; qrow = qrow < nxt.nvalid ? qrow : nxt.nvalid - 1;
#pragma unroll
      for (int d0 = 0; d0 < 8; ++d0) S.qr[d0] = *(const bf16x8*)(nxt.Q + (size_t)qrow * nxt.q_stride + d0 * 16 + hi * 8); }
    SBAR();
    if (act) { finishSM(pA0, pA1, alA, l_reg, pa0, pa1, pa2, pa3); SBAR();
    pv_tile<0>(o, vb0, pa0, pa1, pa2, pa3); }
    if (even) { if (act) { MASKT(pB0, pB1, NT - 1); partialSM(pB0, pB1, G_lds + (NT - 1) * 64, hi, m_reg, mnB, alB); } __syncthreads(); if (act) { RESC(alB);
        finishSM(pB0, pB1, alB, l_reg, pa0, pa1, pa2, pa3); SBAR(); pv_tile<1>(o, vb0, pa0, pa1, pa2, pa3); } }
    SBAR(); VMWN(8); if constexpr (B16) { A_SWRITE_KH(0); SBAR(); } else { A_SWRITE_K(0, B16); SBAR(); A_SLOADN(nxt, V1); SBAR(); }
    if (hi == 0) li_l[r32] = l_reg; asm volatile("s_waitcnt lgkmcnt(0)" ::: "memory");
    float rli[16];
#pragma unroll
    for (int r = 0; r < 16; ++r) rli[r] = __builtin_amdgcn_rcpf(li_l[crow(r, hi)]);
#pragma unroll
    for (int r = 0; r < 16; ++r) { const int orow = wid * QBLK + crow(r, hi); const bool ok = orow < cur.nvalid && (r32 & 1) == 0;
        const size_t ro = (size_t)orow * BRW; const bf16_t* Zp = (const bf16_t*)((const char*)cur.O - WS_BR + WS_ZS);
#pragma unroll
        for (int d0 = 0; d0 < 4; ++d0) { const float v = o[d0][r] * rli[r]; const float vn = __int_as_float(__builtin_amdgcn_update_dpp(0, __float_as_int(v), 0xB1, 0xF, 0xF, false));
            if (ok) { const unsigned zz = *(const unsigned*)(Zp + ro + d0 * 32 + r32);
                *(unsigned*)(cur.O + ro + d0 * 32 + r32) = cvtpk(v * __uint_as_float(zz << 16), vn * __uint_as_float(zz & 0xffff0000u)); } } }
    __syncthreads();
#undef RESC
#undef MASKT
#undef HALF_STEP
}
#undef VMW
#undef VMWN
}

__device__ __forceinline__ int attn_total_items(int L) { return (L & 1) ? (NB * NMH * (SEQ / 256) + DB * NMH) : (NB * NH * (SEQ / 256) + DB * NH + NB * NMH * (SEQ / 256) + DB * NMH); }
__device__ __forceinline__ att::Ref attn_item(const Frame& F, int L, int idx) {
    const int j = L >> 1; att::Ref a;
    const int n_fp = (L & 1) ? 0 : NB * NH * (SEQ / 256), n_fs = (L & 1) ? 0 : DB * NH, n_mp = NB * NMH * (SEQ / 256);
    float* out = F.out(); const bf16_t* qkv = (const bf16_t*)F.qkv(); const bf16_t* qm = (const bf16_t*)F.qm(); bf16_t* br = (bf16_t*)F.br();
    if (idx < n_fp) {
        const int qb = (SEQ / 256 - 1) - idx / (NB * NH), bh = idx % (NB * NH), b = bh / NH, hh = bh % NH; const size_t r0 = (size_t)b * SEQ + (size_t)qb * 256;
        a.Q = qkv + r0 * CONVCH + hh * HD; a.q_stride = CONVCH;
        a.K1 = (const float*)(qkv + (size_t)b * SEQ * CONVCH + MIXW + hh * HD); a.V1 = (const float*)(qkv + (size_t)b * SEQ * CONVCH + 2 * MIXW + hh * HD); a.K2 = a.K1; a.V2 = a.V1;
        a.kv_stride = CONVCH; a.kvb16 = 1; a.jsw = 1 << 20; a.P0 = qb * 256; a.skv = SEQ; a.nvalid = 256;
        a.G = F.fp() + ((size_t)b * NH + hh) * SEQ; a.gref = __hip_atomic_load(a.G + qb * 256, __ATOMIC_RELAXED, __HIP_MEMORY_SCOPE_AGENT);
        { const float qn2 = __hip_atomic_load((const float*)(F.ws() + WS_QN) + bh * 32 + qb, __ATOMIC_RELAXED, __HIP_MEMORY_SCOPE_AGENT);
          const float kn2 = __uint_as_float(__hip_atomic_load(F.ctl() + CW_KN + L * 32 + bh, __ATOMIC_RELAXED, __HIP_MEMORY_SCOPE_AGENT));
          const float thr = a.gref + (160.f + 2.f * sqrtf(qn2) * sqrtf(kn2) * att::C2) * (1.f / att::LOG2E);
          const int t0 = 2 * F.lane, npast = 4 * qb;
          const float f0 = t0 < npast ? __hip_atomic_load(a.G + 64 * t0 + 63, __ATOMIC_RELAXED, __HIP_MEMORY_SCOPE_AGENT) : -3.0e38f;
          const float f1 = t0 + 1 < npast ? __hip_atomic_load(a.G + 64 * (t0 + 1) + 63, __ATOMIC_RELAXED, __HIP_MEMORY_SCOPE_AGENT) : -3.0e38f;
          const int j_lo = __builtin_popcountll(__ballot(f0 > thr)) + __builtin_popcountll(__ballot(f1 > thr));
          a.K1 = (const float*)((const char*)a.K1 + (size_t)j_lo * 64 * CONVCH * 2); a.V1 = (const float*)((const char*)a.V1 + (size_t)j_lo * 64 * CONVCH * 2); a.K2 = a.K1; a.V2 = a.V1; a.G += j_lo * 64; a.P0 -= j_lo * 64; a.skv -= j_lo * 64; }
        a.O = br + r0 * BRW + hh * HD;
    } else if (idx < n_fp + n_fs) {
        const int s = idx - n_fp, bs = s / NH, hh = s % NH; const size_t r0 = (size_t)MP + (size_t)bs * DS;
        a.Q = qkv + r0 * CONVCH + hh * HD; a.q_stride = CONVCH;
        a.K1 = F.in(3) + (((size_t)j * DB + bs) * PAST) * MIXW + hh * HD; a.V1 = F.in(4) + (((size_t)j * DB + bs) * PAST) * MIXW + hh * HD;
        a.K2 = out + O_SFK + ((size_t)j * MS + (size_t)bs * DS) * MIXW + hh * HD - (size_t)PAST * MIXW; a.V2 = out + O_SFV + ((size_t)j * MS + (size_t)bs * DS) * MIXW + hh * HD - (size_t)PAST * MIXW;
        a.kv_stride = MIXW; a.kvb16 = 0; a.jsw = PAST / 64; a.P0 = PAST; a.skv = FS_LEN; a.nvalid = DS;
        a.G = F.fs() + ((size_t)bs * NH + hh) * FS_LEN; a.gref = __hip_atomic_load(a.G + PAST, __ATOMIC_RELAXED, __HIP_MEMORY_SCOPE_AGENT);
        a.O = br + r0 * BRW + hh * HD;
    } else if (idx < n_fp + n_fs + n_mp) {
        const int s = idx - n_fp - n_fs, qb = s / (NB * NMH), bh = s % (NB * NMH), b = bh / NMH, hm = bh % NMH; const size_t r0 = (size_t)b * SEQ + (size_t)qb * 256;
        a.Q = qm + r0 * MEMW + hm * HD; a.q_stride = MEMW;
        a.K1 = out + O_PMK + ((size_t)L * 512 + (size_t)b * NMEM) * MEMW + hm * HD; a.V1 = out + O_PMV + ((size_t)L * 512 + (size_t)b * NMEM) * MEMW + hm * HD; a.K2 = a.K1; a.V2 = a.V1;
        a.kv_stride = MEMW; a.kvb16 = 0; a.jsw = 1 << 20; a.P0 = 1 << 20; a.skv = NMEM; a.nvalid = 256;
        a.G = (const float*)(F.ws() + WS_ZERO); a.gref = 0.f;
        a.O = br + r0 * BRW + MIXW + hm * HD;
    } else {
        const int s = idx - n_fp - n_fs - n_mp, bs = s / NMH, hm = s % NMH; const size_t r0 = (size_t)MP + (size_t)bs * DS;
        a.Q = qm + r0 * MEMW + hm * HD; a.q_stride = MEMW;
        a.K1 = F.in(8) + (((size_t)L * DB + bs) * NMEM) * MEMW + hm * HD; a.V1 = F.in(9) + (((size_t)L * DB + bs) * NMEM) * MEMW + hm * HD; a.K2 = a.K1; a.V2 = a.V1;
        a.kv_stride = MEMW; a.kvb16 = 0; a.jsw = 1 << 20; a.P0 = 1 << 20; a.skv = NMEM; a.nvalid = DS;
        a.G = (const float*)(F.ws() + WS_ZERO); a.gref = 0.f;
        a.O = br + r0 * BRW + MIXW + hm * HD;
    }
    return a;
}
template <bool B16>
__device__ __forceinline__ void attn_run_queue(Frame& F, int L, int qslot, int base, int count) {
    if (count <= 0) return;
    unsigned* qhead = F.ctl() + CW_Q + 64 * qslot;
    volatile LAS int* qs = (volatile LAS int*)(F.lds + att::OFF_Q);
    __syncthreads();
    if (F.tid == 0) { qs[0] = (int)atomicAdd(qhead, 1u); qs[1] = (int)atomicAdd(qhead, 1u); }
    __syncthreads();
    int i0 = qs[0], i1 = qs[1];
    if (i0 < count) {
        att::Ref cur = attn_item(F, L, base + i0);
        att::Seam S;
        att::attn_prime<B16>(cur, (LAS char*)F.lds, S, F.tid);
        for (;;) {
            const bool last = i1 >= count;
            if (F.tid == 0) qs[2] = (int)atomicAdd(qhead, 1u);
            att::Ref nref = cur; if (!last) nref = attn_item(F, L, base + i1);
            { const att::Next nxt = att::next_of(nref); att::attn_block<B16>(cur, nxt, (LAS char*)F.lds, S, F.tid); }
            if (last) break;
            const int i2 = qs[2];
            __syncthreads();
            cur = nref; i0 = i1; i1 = i2;
        }
        asm volatile("s_waitcnt vmcnt(0)" ::: "memory");
    }
    __syncthreads();
}
__device__ __forceinline__ void p_attention(Frame& F, int L, int qslot) {
    const int total = attn_total_items(L), n_fp = (L & 1) ? 0 : NB * NH * (SEQ / 256);
    if (!(L & 1)) attn_run_queue<true>(F, L, qslot + 8, 0, n_fp);
    attn_run_queue<false>(F, L, qslot, n_fp, total - n_fp);
}
namespace gdn {
constexpr int NU = 3072 + 384;
constexpr size_t T16 = 16384;
constexpr size_t G_KH = 0, G_QH = G_KH + NU * T16, G_KHT = G_QH + NU * T16, G_VT = G_KHT + NU * T16, G_QD = G_VT + NU * T16, G_KTT = G_QD + NU * T16;
constexpr size_t G_W = G_KTT + NU * T16, G_QK = G_W + NU * T16, G_U = G_QK + NU * 8192, G_GB = G_U + NU * 32768, G_O = G_GB + NU * 512, G_END = G_O + (size_t)MR * MIXW * 4;
static_assert(WS_GDN + G_END <= WS_END_MIN, "GDN workspace");

__device__ __forceinline__ unsigned cvtpk(float lo, float hi) { unsigned r; asm volatile("v_cvt_pk_bf16_f32 %0, %1, %2" : "=v"(r) : "v"(lo), "v"(hi)); return r; }
__device__ __forceinline__ int crow(int r, int hi) { return (r & 3) + 8 * (r >> 2) + 4 * hi; }

struct UnitInfo { int hh, nvalid, tabs; size_t row0; const float* hist; };
__device__ __forceinline__ UnitInfo unit_info(const Frame& F, int L, int u) {
    UnitInfo q; const int j = L >> 1;
    if (u < 3072) { const int b = u / 1536, n = u & 127; q.hh = (u >> 7) % NH; q.row0 = (size_t)b * SEQ + (size_t)n * 64; q.nvalid = 64; q.tabs = n * 64; q.hist = nullptr; }
    else { const int s = u - 3072, bs = s / NH; q.hh = s % NH; q.row0 = (size_t)MP + (size_t)bs * DS; q.nvalid = DS; q.tabs = 0; q.hist = F.in(7) + ((size_t)j * DB + bs) * 3 * CONVCH; }
    return q;
}

struct PreRegs { bf16x8 x[11]; };
__device__ __forceinline__ void pre_load(Frame& F, int L, int u, PreRegs& R) {
    const int j = L >> 1; const UnitInfo q = unit_info(F, L, u);
    const bf16_t* qkv = (const bf16_t*)F.qkv();
    int tid = F.tid; asm volatile("" : "+v"(tid));
    const int rg = tid / 48, cg = tid - rg * 48, sel = cg >> 4, d0 = (cg & 15) * 8, t0 = rg * 8, col = sel * MIXW + q.hh * HD + d0;
    if (tid < 384) {
        const char* ub = (const char*)qkv;
        int off0 = (int)(((long)q.row0 + t0 - 3) * CONVCH + col) * 2; asm volatile("" : "+v"(off0));
#pragma unroll
        for (int k = 0; k < 11; ++k) { const int rho = t0 - 3 + k;
            const bool valid = rho >= 0 ? rho < q.nvalid : (q.hist == nullptr && q.tabs + rho >= 0);
            const int off = valid ? off0 + k * (CONVCH * 2) : 0;
            bf16x8 v = *(const bf16x8*)(ub + (unsigned)off);
            if (!valid) v = bf16x8{};
            R.x[k] = v; }
        if (q.hist != nullptr && t0 == 0) {
#pragma unroll
            for (int k = 0; k < 3; ++k) { const float* hp = q.hist + (size_t)k * CONVCH + col; const f32x4 a = *(const f32x4*)hp, b = *(const f32x4*)(hp + 4);
                u32x4 pk; pk.x = pk2(a[0], a[1]); pk.y = pk2(a[2], a[3]); pk.z = pk2(b[0], b[1]); pk.w = pk2(b[2], b[3]); R.x[k] = __builtin_bit_cast(bf16x8, pk); } }
    }
}
__device__ __forceinline__ void pre_compute(Frame& F, int L, int u, const PreRegs& R) {
    const int j = L >> 1; const UnitInfo q = unit_info(F, L, u);
    LAS float* GRAW = (LAS float*)F.lds;
    LAS float* GT = GRAW + 64;
    LAS float* BT = GT + 64;
    unsigned char* gw = F.ws() + WS_GDN;
    int tid = F.tid; asm volatile("" : "+v"(tid));
    const int rg = tid / 48, cg = tid - rg * 48, sel = cg >> 4, d0 = (cg & 15) * 8, t0 = rg * 8, col = sel * MIXW + q.hh * HD + d0;
    const bool act = tid < 384;
    f32x4 w[4][2];
    if (act) { const float* cw = F.in(16) + (size_t)j * CONVW * CONVCH + col;
#pragma unroll
        for (int jj = 0; jj < 4; ++jj) { w[jj][0] = *(const f32x4*)(cw + (size_t)jj * CONVCH); w[jj][1] = *(const f32x4*)(cw + (size_t)jj * CONVCH + 4); } }
    __syncthreads();
    if (tid >= 384 && tid < 448) { const int t = tid - 384; const bool ok = t < q.nvalid;
        float run = ok ? F.ga()[(q.row0 + t) * NH + q.hh] : 0.f; const float bb = ok ? F.beta()[(q.row0 + t) * NH + q.hh] : 0.f;
#pragma unroll
        for (int o = 1; o < 64; o <<= 1) { const float up = __int_as_float(__builtin_amdgcn_ds_bpermute(((t - o) & 63) << 2, __float_as_int(run))); if (t >= o) run += up; }
        GT[t] = run; BT[t] = bb; float* gb = (float*)(gw + G_GB + (size_t)u * 512); gb[t] = run; gb[64 + t] = bb; }
    __syncthreads();
    if (act) {
        float y[8][8];
#pragma unroll
        for (int i = 0; i < 8; ++i)
#pragma unroll
            for (int e = 0; e < 8; ++e) y[i][e] = 0.f;
#pragma unroll
        for (int k = 0; k < 11; ++k) {
            float xf[8];
#pragma unroll
            for (int e = 0; e < 8; ++e) xf[e] = __uint_as_float((unsigned)(unsigned short)R.x[k][e] << 16);
#pragma unroll
            for (int jj = 0; jj < 4; ++jj) { const int i = k - jj; if (i >= 0 && i < 8) {
#pragma unroll
                for (int e = 0; e < 8; ++e) y[i][e] += w[jj][e >> 2][e & 3] * xf[e]; } }
        }
#pragma unroll
        for (int i = 0; i < 8; ++i)
#pragma unroll
            for (int e = 0; e < 8; ++e) y[i][e] = (t0 + i) < q.nvalid ? siluf(y[i][e]) : 0.f;
        if (sel < 2) {
#pragma unroll
            for (int i = 0; i < 8; ++i) { float ss = 0.f;
#pragma unroll
                for (int e = 0; e < 8; ++e) ss += y[i][e] * y[i][e];
                ss += shfl_xor_l(ss, 1, F.lane); ss += shfl_xor_l(ss, 2, F.lane); ss += shfl_xor_l(ss, 4, F.lane); ss += shfl_xor_l(ss, 8, F.lane);
                const float rn = (1.f / sqrtf(ss + EPS)) * (sel == 0 ? ATT_SCALE : 1.f);
#pragma unroll
                for (int e = 0; e < 8; ++e) y[i][e] *= rn; }
        }
        const float glast = GT[63];
#define ROW8(i_, s_) ({ u32x4 p_; p_.x = cvtpk(y[i_][0] * (s_), y[i_][1] * (s_)); p_.y = cvtpk(y[i_][2] * (s_), y[i_][3] * (s_)); p_.z = cvtpk(y[i_][4] * (s_), y[i_][5] * (s_)); p_.w = cvtpk(y[i_][6] * (s_), y[i_][7] * (s_)); p_; })
        if (sel == 0) {
            const unsigned lo_ = (unsigned)(t0 * 128 + d0) * 2u; bf16_t* QH = (bf16_t*)(gw + G_QH + (size_t)u * T16 + lo_); bf16_t* QD = (bf16_t*)(gw + G_QD + (size_t)u * T16 + lo_);
#pragma unroll
            for (int i = 0; i < 8; ++i) { *(u32x4*)(QH + i * 128) = ROW8(i, 1.f); const float eg = __expf(GT[t0 + i]); *(u32x4*)(QD + i * 128) = ROW8(i, eg); }
        } else if (sel == 1) {
            const unsigned lo_ = (unsigned)(t0 * 128 + d0) * 2u, lt_ = (unsigned)(d0 * 64 + t0) * 2u; bf16_t* KH = (bf16_t*)(gw + G_KH + (size_t)u * T16 + lo_); bf16_t* KHT = (bf16_t*)(gw + G_KHT + (size_t)u * T16 + lt_); bf16_t* KTT = (bf16_t*)(gw + G_KTT + (size_t)u * T16 + lt_);
            float ek[8];
#pragma unroll
            for (int i = 0; i < 8; ++i) { *(u32x4*)(KH + i * 128) = ROW8(i, 1.f); ek[i] = __expf(glast - GT[t0 + i]); }
#pragma unroll
            for (int e = 0; e < 8; ++e) { u32x4 c0, c1;
                c0.x = cvtpk(y[0][e], y[1][e]); c0.y = cvtpk(y[2][e], y[3][e]); c0.z = cvtpk(y[4][e], y[5][e]); c0.w = cvtpk(y[6][e], y[7][e]);
                c1.x = cvtpk(y[0][e] * ek[0], y[1][e] * ek[1]); c1.y = cvtpk(y[2][e] * ek[2], y[3][e] * ek[3]); c1.z = cvtpk(y[4][e] * ek[4], y[5][e] * ek[5]); c1.w = cvtpk(y[6][e] * ek[6], y[7][e] * ek[7]);
                *(u32x4*)(KHT + e * 64) = c0; *(u32x4*)(KTT + e * 64) = c1; }
        } else {
            const unsigned lt_ = (unsigned)(d0 * 64 + t0) * 2u; bf16_t* VT = (bf16_t*)(gw + G_VT + (size_t)u * T16 + lt_);
#pragma unroll
            for (int e = 0; e < 8; ++e) { u32x4 c0; c0.x = cvtpk(y[0][e], y[1][e]); c0.y = cvtpk(y[2][e], y[3][e]); c0.z = cvtpk(y[4][e], y[5][e]); c0.w = cvtpk(y[6][e], y[7][e]); *(u32x4*)(VT + e * 64) = c0; }
        }
#undef ROW8
    }
}
__device__ __forceinline__ void p_gdn_pre(Frame& F, int L) {
    int u = F.bid; if (u >= NU) return;
    PreRegs A, B; pre_load(F, L, u, A);
#pragma unroll 1
    for (;;) {
        { const int un = u + F.G; const bool more = un < NU; pre_load(F, L, more ? un : u, B); pre_compute(F, L, u, A); if (!more) break; u = un; }
        { const int un = u + F.G; const bool more = un < NU; pre_load(F, L, more ? un : u, A); pre_compute(F, L, u, B); if (!more) break; u = un; }
    }
}

constexpr int TP = 72;
constexpr int PW = 64 * TP * 2 + 512;
__device__ __forceinline__ void solve_unit(Frame& F, int u) {
    unsigned char* gw = F.ws() + WS_GDN;
    const int lane = F.lane, r32 = lane & 31, hi = lane >> 5;
    LAS bf16_t* Tl = (LAS bf16_t*)(F.lds + F.wave * PW); LAS float* gt = (LAS float*)(F.lds + F.wave * PW + 64 * TP * 2); LAS float* bt = gt + 64;
    const float* gb = (const float*)(gw + G_GB + (size_t)u * 512);
    const float Gl = gb[lane], Bl = gb[64 + lane];
    gt[lane] = Gl; bt[lane] = Bl;
    const bf16_t* KH = (const bf16_t*)(gw + G_KH + (size_t)u * T16); const bf16_t* QH = (const bf16_t*)(gw + G_QH + (size_t)u * T16);
    const bf16_t* KHT = (const bf16_t*)(gw + G_KHT + (size_t)u * T16); const bf16_t* VT = (const bf16_t*)(gw + G_VT + (size_t)u * T16);
    bf16_t* Wg = (bf16_t*)(gw + G_W + (size_t)u * T16); bf16_t* QKg = (bf16_t*)(gw + G_QK + (size_t)u * 8192); f32x4* Ug = (f32x4*)(gw + G_U + (size_t)u * 32768);
    bf16x8 kf[2][8];
#pragma unroll
    for (int mt = 0; mt < 2; ++mt)
#pragma unroll
        for (int ks = 0; ks < 8; ++ks) kf[mt][ks] = *(const bf16x8*)(KH + (32 * mt + r32) * 128 + 16 * ks + 8 * hi);
    {
        bf16x8 qf[2][8];
#pragma unroll
        for (int nt = 0; nt < 2; ++nt)
#pragma unroll
            for (int ks = 0; ks < 8; ++ks) qf[nt][ks] = *(const bf16x8*)(QH + (32 * nt + r32) * 128 + 16 * ks + 8 * hi);
#pragma unroll
        for (int nt = 0; nt < 2; ++nt)
#pragma unroll
            for (int mt = 0; mt < 2; ++mt) {
                const int i = 32 * nt + r32; u32x2 w[4];
                if (mt <= nt) {
                    f32x16 acc = {};
#pragma unroll
                    for (int ks = 0; ks < 8; ++ks) acc = __builtin_amdgcn_mfma_f32_32x32x16_bf16(kf[mt][ks], qf[nt][ks], acc, 0, 0, 0);
                    const float Gi = gt[i];
#pragma unroll
                    for (int g = 0; g < 4; ++g) { const int j0 = 32 * mt + 8 * g + 4 * hi; const f32x4 gj = *(const LAS f32x4*)(gt + j0); float v[4];
#pragma unroll
                        for (int e = 0; e < 4; ++e) v[e] = (i >= j0 + e) ? acc[4 * g + e] * __expf(Gi - gj[e]) : 0.f;
                        w[g].x = cvtpk(v[0], v[1]); w[g].y = cvtpk(v[2], v[3]); }
                } else {
#pragma unroll
                    for (int g = 0; g < 4; ++g) { w[g].x = 0u; w[g].y = 0u; }
                }
#pragma unroll
                for (int g = 0; g < 4; ++g) *(u32x2*)(QKg + i * 64 + 32 * mt + 8 * g + 4 * hi) = w[g];
            }
    }
    float Arow[64];
    {
        f32x16 k00 = {}, k10 = {}, k11 = {};
#pragma unroll
        for (int ks = 0; ks < 8; ++ks) { k00 = __builtin_amdgcn_mfma_f32_32x32x16_bf16(kf[0][ks], kf[0][ks], k00, 0, 0, 0);
            k10 = __builtin_amdgcn_mfma_f32_32x32x16_bf16(kf[1][ks], kf[0][ks], k10, 0, 0, 0); k11 = __builtin_amdgcn_mfma_f32_32x32x16_bf16(kf[1][ks], kf[1][ks], k11, 0, 0, 0); }
#pragma unroll
        for (int r = 0; r < 16; ++r) {
            { auto rr = __builtin_amdgcn_permlane32_swap(__float_as_uint(k00[r]), 0u, false, false);
              Arow[crow(r, 0)] = __uint_as_float(rr[0]); Arow[crow(r, 1)] = __uint_as_float(rr[1]); }
            { auto rr = __builtin_amdgcn_permlane32_swap(__float_as_uint(k10[r]), __float_as_uint(k11[r]), false, false);
              Arow[32 + crow(r, 0)] = __uint_as_float(rr[0]); Arow[32 + crow(r, 1)] = __uint_as_float(rr[1]); }
        }
#pragma unroll
        for (int i = 0; i < 64; ++i) { const float gi = gt[i], bi = bt[i]; Arow[i] = (lane < i) ? bi * Arow[i] * __expf(gi - Gl) : 0.f; }
    }
    float x[64];
#pragma unroll
    for (int i = 0; i < 64; ++i) {
        float ac0 = (lane == i) ? 1.f : 0.f, ac1 = 0.f, ac2 = 0.f, ac3 = 0.f;
#pragma unroll
        for (int jj = 0; jj < i; ++jj) { const float a = __uint_as_float(__builtin_amdgcn_readlane(__float_as_uint(Arow[i]), jj));
            if ((jj & 3) == 0) ac0 -= a * x[jj]; else if ((jj & 3) == 1) ac1 -= a * x[jj]; else if ((jj & 3) == 2) ac2 -= a * x[jj]; else ac3 -= a * x[jj]; }
        x[i] = (ac0 + ac1) + (ac2 + ac3);
    }
#pragma unroll
    for (int i = 0; i < 64; ++i) Tl[i * TP + lane] = f2bf(x[i] * Bl);
#pragma unroll 1
    for (int nt = 0; nt < 4; ++nt) {
        f32x16 a0 = {}, a1 = {};
#pragma unroll
        for (int ks = 0; ks < 4; ++ks) { const bf16x8 bfr = *(const bf16x8*)(VT + (32 * nt + r32) * 64 + 16 * ks + 8 * hi);
            a0 = __builtin_amdgcn_mfma_f32_32x32x16_bf16(*(const LAS bf16x8*)(Tl + r32 * TP + 16 * ks + 8 * hi), bfr, a0, 0, 0, 0);
            a1 = __builtin_amdgcn_mfma_f32_32x32x16_bf16(*(const LAS bf16x8*)(Tl + (32 + r32) * TP + 16 * ks + 8 * hi), bfr, a1, 0, 0, 0); }
#pragma unroll
        for (int qd = 0; qd < 4; ++qd) { Ug[((nt * 2 + 0) * 4 + qd) * 64 + lane] = (f32x4){a0[4 * qd], a0[4 * qd + 1], a0[4 * qd + 2], a0[4 * qd + 3]};
            Ug[((nt * 2 + 1) * 4 + qd) * 64 + lane] = (f32x4){a1[4 * qd], a1[4 * qd + 1], a1[4 * qd + 2], a1[4 * qd + 3]}; }
    }
    { const float be = Bl * __expf(Gl);
#pragma unroll
      for (int i = 0; i < 64; ++i) Tl[i * TP + lane] = f2bf(x[i] * be); }
#pragma unroll 1
    for (int mt = 0; mt < 4; ++mt) {
        f32x16 a0 = {}, a1 = {};
#pragma unroll
        for (int ks = 0; ks < 4; ++ks) { const bf16x8 afr = *(const bf16x8*)(KHT + (32 * mt + r32) * 64 + 16 * ks + 8 * hi);
            a0 = __builtin_amdgcn_mfma_f32_32x32x16_bf16(afr, *(const LAS bf16x8*)(Tl + r32 * TP + 16 * ks + 8 * hi), a0, 0, 0, 0);
            a1 = __builtin_amdgcn_mfma_f32_32x32x16_bf16(afr, *(const LAS bf16x8*)(Tl + (32 + r32) * TP + 16 * ks + 8 * hi), a1, 0, 0, 0); }
#pragma unroll
        for (int g = 0; g < 4; ++g) { u32x2 w0, w1; w0.x = cvtpk(-a0[4 * g], -a0[4 * g + 1]); w0.y = cvtpk(-a0[4 * g + 2], -a0[4 * g + 3]); w1.x = cvtpk(-a1[4 * g], -a1[4 * g + 1]); w1.y = cvtpk(-a1[4 * g + 2], -a1[4 * g + 3]);
            *(u32x2*)(Wg + r32 * 128 + 32 * mt + 8 * g + 4 * hi) = w0; *(u32x2*)(Wg + (32 + r32) * 128 + 32 * mt + 8 * g + 4 * hi) = w1; }
    }
}
__device__ __forceinline__ void p_gdn_solve(Frame& F) {
    const int gwv = F.wave * F.G + F.bid, NGW = F.G * NWAVES;
#pragma unroll 1
    for (int u = gwv; u < NU; u += NGW) solve_unit(F, u);
}

constexpr int P128 = 132, P64 = 68;
constexpr int SB_W = 0, SB_QD = SB_W + 64 * P128 * 2, SB_QK = SB_QD + 64 * P128 * 2, SB_KTT = SB_QK + 64 * P64 * 2, SB_BYTES = SB_KTT + 128 * P64 * 2;
static_assert(2 * SB_BYTES <= 131072, "scan LDS");
__device__ __forceinline__ bf16x8 cvt8(const f32x16& a, int s) {
    u32x4 w; w.x = cvtpk(a[8 * s], a[8 * s + 1]); w.y = cvtpk(a[8 * s + 2], a[8 * s + 3]); w.z = cvtpk(a[8 * s + 4], a[8 * s + 5]); w.w = cvtpk(a[8 * s + 6], a[8 * s + 7]); return __builtin_bit_cast(bf16x8, w);
}
__device__ __forceinline__ bf16x8 afrag(const LAS bf16_t* base, int pitch, int row, int k0, int hi) {
    const LAS bf16_t* p = base + row * pitch + k0 + 4 * hi;
    const u32x2 lo = *(const LAS u32x2*)p, hi2 = *(const LAS u32x2*)(p + 8);
    u32x4 w = {lo.x, lo.y, hi2.x, hi2.y}; return __builtin_bit_cast(bf16x8, w);
}
template <int CW>
__device__ __forceinline__ void scan_seq(Frame& F, int L, int s, int part) {
    const int j = L >> 1; const int tid = F.tid, lane = F.lane, r32 = lane & 31, hi = lane >> 5, wv = F.wave;
    unsigned char* gw = F.ws() + WS_GDN;
    int u0, nchunk, nvalid, hh; size_t row0; const float* S0; float* Sout;
    if (s < NB * NH) { const int b = s / NH; hh = s % NH; u0 = s * 128; nchunk = 128; nvalid = 64; row0 = (size_t)b * SEQ; S0 = nullptr; Sout = F.out() + O_PGS + (((size_t)j * NB + b) * NH + hh) * HD * HD; }
    else { const int q = s - NB * NH, bs = q / NH; hh = q % NH; u0 = 3072 + q; nchunk = 1; nvalid = DS; row0 = (size_t)MP + (size_t)bs * DS;
        S0 = F.in(6) + (((size_t)j * DB + bs) * NH + hh) * HD * HD; Sout = F.out() + O_SGS + (((size_t)j * DB + bs) * NH + hh) * HD * HD; }
    float* Og = (float*)(gw + G_O);
    __syncthreads();
    if (wv >= 4) {
        const int t2 = tid - 256;
        u32x4 sa[14], sb[14];
#define LW16(p_, v_) do { LAS u32x2* q_ = (LAS u32x2*)(p_); q_[0] = (u32x2){(v_).x, (v_).y}; q_[1] = (u32x2){(v_).z, (v_).w}; } while (0)
#define ST_LOAD(st, u_) do { const unsigned char* bw = gw + G_W + (size_t)(u_) * T16; const unsigned char* bq = gw + G_QD + (size_t)(u_) * T16; \
            const unsigned char* bk = gw + G_QK + (size_t)(u_) * 8192; const unsigned char* bt_ = gw + G_KTT + (size_t)(u_) * T16; \
            unsigned lo_ = (unsigned)t2 * 16u; asm volatile("" : "+v"(lo_)); \
            _Pragma("unroll") for (int k = 0; k < 4; ++k) { st[k] = *(const u32x4*)(bw + 4096 * k + lo_); st[4 + k] = *(const u32x4*)(bq + 4096 * k + lo_); st[10 + k] = *(const u32x4*)(bt_ + 4096 * k + lo_); } \
            st[8] = *(const u32x4*)(bk + lo_); st[9] = *(const u32x4*)(bk + 4096 + lo_); } while (0)
#define ST_WRITE(st, buf_) do { LAS unsigned char* B_ = F.lds + (buf_) * SB_BYTES; \
            _Pragma("unroll") for (int k = 0; k < 4; ++k) { LW16(B_ + SB_W + (((t2 >> 4) + 16 * k) * P128 + (t2 & 15) * 8) * 2, st[k]); LW16(B_ + SB_QD + (((t2 >> 4) + 16 * k) * P128 + (t2 & 15) * 8) * 2, st[4 + k]); \
                LW16(B_ + SB_KTT + (((t2 >> 3) + 32 * k) * P64 + (t2 & 7) * 8) * 2, st[10 + k]); } \
            LW16(B_ + SB_QK + ((t2 >> 3) * P64 + (t2 & 7) * 8) * 2, st[8]); LW16(B_ + SB_QK + (((t2 >> 3) + 32) * P64 + (t2 & 7) * 8) * 2, st[9]); } while (0)
#define UCL(k_) (u0 + ((k_) < nchunk ? (k_) : nchunk - 1))
        ST_LOAD(sa, u0); ST_WRITE(sa, 0); ST_LOAD(sb, UCL(1));
        __syncthreads();
#pragma unroll 1
        for (int n = 0;;) {
            ST_LOAD(sa, UCL(n + 2)); ST_WRITE(sb, (n + 1) & 1);
            asm volatile("s_waitcnt lgkmcnt(0)\n\ts_barrier" ::: "memory"); if (++n >= nchunk) break;
            ST_LOAD(sb, UCL(n + 2)); ST_WRITE(sa, (n + 1) & 1);
            asm volatile("s_waitcnt lgkmcnt(0)\n\ts_barrier" ::: "memory"); if (++n >= nchunk) break;
        }
#undef UCL
#undef ST_LOAD
#undef ST_WRITE
#undef LW16
    } else if (wv >= CW) {
        __syncthreads();
#pragma unroll 1
        for (int n = 0; n < nchunk; ++n) asm volatile("s_waitcnt lgkmcnt(0)\n\ts_barrier" ::: "memory");
    } else {
        const int cs = part * CW + wv;
        f32x16 S[4];
#pragma unroll
        for (int t = 0; t < 4; ++t)
#pragma unroll
            for (int r = 0; r < 16; ++r) S[t][r] = S0 ? S0[(size_t)(32 * t + crow(r, hi)) * HD + 32 * cs + r32] : 0.f;
        f32x16 U0, U1;
#define U_LOAD(u_) do { const unsigned char* Ub = gw + G_U + (size_t)(u_) * 32768 + (size_t)cs * 8192; unsigned ul_ = (unsigned)lane * 16u; asm volatile("" : "+v"(ul_)); \
            _Pragma("unroll") for (int qd = 0; qd < 4; ++qd) { const f32x4 a = *(const f32x4*)(Ub + qd * 1024 + ul_), b = *(const f32x4*)(Ub + 4096 + qd * 1024 + ul_); \
                U0[4 * qd] = a[0]; U0[4 * qd + 1] = a[1]; U0[4 * qd + 2] = a[2]; U0[4 * qd + 3] = a[3]; U1[4 * qd] = b[0]; U1[4 * qd + 1] = b[1]; U1[4 * qd + 2] = b[2]; U1[4 * qd + 3] = b[3]; } } while (0)
        U_LOAD(u0);
        float glraw = ((const float*)(gw + G_GB + (size_t)u0 * 512))[63];
        __syncthreads();
#pragma unroll 1
        for (int n = 0; n < nchunk; ++n) {
            const int u = u0 + n; const bool more = n + 1 < nchunk;
            const LAS unsigned char* B_ = F.lds + (n & 1) * SB_BYTES;
            const LAS bf16_t* Wl = (const LAS bf16_t*)(B_ + SB_W); const LAS bf16_t* QDl = (const LAS bf16_t*)(B_ + SB_QD);
            const LAS bf16_t* QKl = (const LAS bf16_t*)(B_ + SB_QK); const LAS bf16_t* KTl = (const LAS bf16_t*)(B_ + SB_KTT);
            const float gl = __expf(glraw);
            glraw = ((const float*)(gw + G_GB + (size_t)(more ? u + 1 : u) * 512))[63];
            f32x16 o0 = {}, o1 = {}, vn0 = {}, vn1 = {};
            bf16x8 fp[3][4];
#define LOADG(dst, g_) do { const int k0 = 16 * (g_); dst[0] = afrag(Wl, P128, r32, k0, hi); dst[1] = afrag(Wl, P128, 32 + r32, k0, hi); dst[2] = afrag(QDl, P128, r32, k0, hi); dst[3] = afrag(QDl, P128, 32 + r32, k0, hi); } while (0)
            LOADG(fp[0], 0); LOADG(fp[1], 1);
#pragma unroll
            for (int gq = 0; gq < 8; ++gq) {
                const bf16x8 bfr = cvt8(S[gq >> 1], gq & 1);
                vn0 = __builtin_amdgcn_mfma_f32_32x32x16_bf16(fp[gq % 3][0], bfr, vn0, 0, 0, 0); vn1 = __builtin_amdgcn_mfma_f32_32x32x16_bf16(fp[gq % 3][1], bfr, vn1, 0, 0, 0);
                o0 = __builtin_amdgcn_mfma_f32_32x32x16_bf16(fp[gq % 3][2], bfr, o0, 0, 0, 0); o1 = __builtin_amdgcn_mfma_f32_32x32x16_bf16(fp[gq % 3][3], bfr, o1, 0, 0, 0);
                __builtin_amdgcn_sched_barrier(0);
                if (gq + 2 < 8) LOADG(fp[(gq + 2) % 3], gq + 2);
            }
#undef LOADG
            bf16x8 fa[2][8];
            __builtin_amdgcn_sched_barrier(0);
#pragma unroll
            for (int t = 0; t < 4; ++t)
#pragma unroll
                for (int r = 0; r < 16; ++r) S[t][r] *= gl;
#pragma unroll
            for (int r = 0; r < 16; ++r) { vn0[r] += U0[r]; vn1[r] += U1[r]; }
            bf16x8 vb[4]; vb[0] = cvt8(vn0, 0); vb[1] = cvt8(vn0, 1); vb[2] = cvt8(vn1, 0); vb[3] = cvt8(vn1, 1);
            __builtin_amdgcn_sched_barrier(0);
            U_LOAD(more ? u + 1 : u);
#pragma unroll
            for (int c = 0; c < 4; ++c) { fa[0][2 * c] = afrag(QKl, P64, r32, 16 * c, hi); fa[0][2 * c + 1] = afrag(QKl, P64, 32 + r32, 16 * c, hi); }
#pragma unroll
            for (int c = 0; c < 4; ++c) { fa[1][c] = afrag(KTl, P64, r32, 16 * c, hi); fa[1][4 + c] = afrag(KTl, P64, 32 + r32, 16 * c, hi); }
#pragma unroll
            for (int c = 0; c < 4; ++c) { o0 = __builtin_amdgcn_mfma_f32_32x32x16_bf16(fa[0][2 * c], vb[c], o0, 0, 0, 0); o1 = __builtin_amdgcn_mfma_f32_32x32x16_bf16(fa[0][2 * c + 1], vb[c], o1, 0, 0, 0); }
#pragma unroll
            for (int c = 0; c < 4; ++c) S[0] = __builtin_amdgcn_mfma_f32_32x32x16_bf16(fa[1][c], vb[c], S[0], 0, 0, 0);
            __builtin_amdgcn_sched_barrier(0);
#pragma unroll
            for (int c = 0; c < 4; ++c) { fa[0][c] = afrag(KTl, P64, 64 + r32, 16 * c, hi); fa[0][4 + c] = afrag(KTl, P64, 96 + r32, 16 * c, hi); }
            __builtin_amdgcn_sched_barrier(0);
#pragma unroll
            for (int c = 0; c < 4; ++c) S[1] = __builtin_amdgcn_mfma_f32_32x32x16_bf16(fa[1][4 + c], vb[c], S[1], 0, 0, 0);
#pragma unroll
            for (int c = 0; c < 4; ++c) { S[2] = __builtin_amdgcn_mfma_f32_32x32x16_bf16(fa[0][c], vb[c], S[2], 0, 0, 0); S[3] = __builtin_amdgcn_mfma_f32_32x32x16_bf16(fa[0][4 + c], vb[c], S[3], 0, 0, 0); }
            unsigned char* ob = (unsigned char*)(Og + (row0 + (size_t)n * 64) * MIXW + hh * HD + 32 * cs);
            unsigned ol_ = ((unsigned)(4 * hi) * MIXW + (unsigned)r32) * 4u; asm volatile("" : "+v"(ol_));
#pragma unroll
            for (int r = 0; r < 16; ++r) { const int i0 = (r & 3) + 8 * (r >> 2);
                if (i0 + 4 * hi < nvalid) *(float*)(ob + (size_t)i0 * MIXW * 4 + ol_) = o0[r];
                if (32 + i0 + 4 * hi < nvalid) *(float*)(ob + (size_t)(32 + i0) * MIXW * 4 + ol_) = o1[r]; }
            asm volatile("s_waitcnt lgkmcnt(0)\n\ts_barrier" ::: "memory");
        }
#undef U_LOAD
#pragma unroll
        for (int t = 0; t < 4; ++t)
#pragma unroll
            for (int r = 0; r < 16; ++r) Sout[(size_t)(32 * t + crow(r, hi)) * HD + 32 * cs + r32] = S[t][r];
    }
}
__device__ __forceinline__ void p_gdn_scan(Frame& F, int L) {
    constexpr int NPW = NB * NH * 4;
    if (F.bid < NPW) { const int w = F.bid; scan_seq<1>(F, L, (w & 7) + 8 * (w >> 5), (w >> 3) & 3); }
    else { const int nw = F.G - NPW;
#pragma unroll 1
        for (int q = F.bid - NPW; q < DB * NH; q += nw) scan_seq<4>(F, L, NB * NH + q, 0);
        if (L == 1) convert_weights(F, 2, 4, F.bid - NPW, nw); }
}
__device__ __forceinline__ void p_gdn_post(Frame& F, int L) {
    const int j = L >> 1; const int gwv = F.bid * NWAVES + F.wave, NGW = F.G * NWAVES;
    const float* Og = (const float*)(F.ws() + WS_GDN + G_O); const bf16_t* zs = (const bf16_t*)F.zs(); bf16_t* br = (bf16_t*)F.br();
    const f32x2 gn = *(const f32x2*)(F.in(19) + (size_t)j * HD + 2 * F.lane);
#pragma unroll 1
    for (int it0 = gwv; it0 < MR * NH; it0 += 4 * NGW) {
        f32x2 o[4]; unsigned zz[4]; size_t off[4];
#pragma unroll
        for (int k = 0; k < 4; ++k) { int it = it0 + k * NGW; if (it >= MR * NH) it = it0; const int row = it / NH, hh = it % NH; off[k] = (size_t)row * BRW + hh * HD + 2 * F.lane;
            o[k] = *(const f32x2*)(Og + (size_t)row * MIXW + hh * HD + 2 * F.lane); zz[k] = *(const unsigned*)(zs + off[k]); }
#pragma unroll
        for (int k = 0; k < 4; ++k) { const float rstd = 1.f / sqrtf(wave_sum(o[k].x * o[k].x + o[k].y * o[k].y, F.lane) * (1.f / HD) + EPS);
            if (it0 + k * NGW < MR * NH) *(unsigned*)(br + off[k]) = pk2(o[k].x * rstd * gn.x * __uint_as_float(zz[k] << 16), o[k].y * rstd * gn.y * __uint_as_float(zz[k] & 0xffff0000u)); }
    }
}
}
constexpr int LDS_BYTES = 147456;
constexpr int MISC_OFF = 131072 + 320;
constexpr int NPH = 31;
#ifndef N_LAUNCHES
#define N_LAUNCHES 1
#endif

struct Args { const float* in[22]; float* out; unsigned char* ws; int ph_lo, ph_hi; };

__global__ void __launch_bounds__(NT, 2) fwd(Args args) {
    extern __shared__ __attribute__((aligned(16))) unsigned char lds_raw[];
    Frame F;
    F.lds = (LAS unsigned char*)lds_raw;
    F.tid = threadIdx.x; F.lane = F.tid & 63; F.wave = __builtin_amdgcn_readfirstlane(F.tid >> 6);
    F.G = gridDim.x; F.bid = blockIdx.x;
    volatile LAS unsigned* MISC = (volatile LAS unsigned*)(F.lds + MISC_OFF);
    if (F.tid < 32) MISC[F.tid] = 0u;
    if (F.tid < 24) { const unsigned long long v = F.tid < 22 ? (unsigned long long)args.in[F.tid] : (F.tid == 22 ? (unsigned long long)args.out : (unsigned long long)args.ws);
        ((LAS unsigned long long*)(F.lds + PTR_OFF))[F.tid] = v; }
    __syncthreads();
    XcdBarrier bar; bar.bar = F.ctl() + CW_BAR; bar.x = 0; bar.st = nullptr;
    const bool multi = (args.ph_hi - args.ph_lo) > 1;
    if (multi) bar = xcd_barrier_post(F.ctl() + CW_BAR, MISC + 8, F.tid);
    const int lo = args.ph_lo, hi = args.ph_hi;
#define IN(k) (lo <= (k) && (k) < hi)
#define PHASE_FRAME() F.tid = F.wave * 64 + (int)__builtin_amdgcn_mbcnt_hi(~0u, __builtin_amdgcn_mbcnt_lo(~0u, 0u)); asm volatile("" : "+v"(F.tid)); asm volatile("" : "+s"(F.bid), "+s"(F.G)); { unsigned l_ = (unsigned)(size_t)F.lds; asm volatile("" : "+s"(l_)); F.lds = (LAS unsigned char*)(size_t)l_; } F.lane = F.tid & 63
#define SEAM(k) do { if (IN(k) && ((k) + 1 < hi)) { xcd_barrier(bar, F.wave * 64 + (int)__builtin_amdgcn_mbcnt_hi(~0u, __builtin_amdgcn_mbcnt_lo(~0u, 0u))); } } while (0)

    { if (IN(0)) { PHASE_FRAME(); p_prologue(F); p_norm(F, 0); } } SEAM(0);
#ifndef PROBE_KIND
#define PROBE_KIND -1
#endif
#define REPS(kind_) ((PROBE_KIND) == (kind_) ? 2 : 1)
#define PDUP(kind_, ...) { constexpr int qrep_ = 0; __VA_ARGS__ } if ((PROBE_KIND) == (kind_)) { XBAR(); { constexpr int qrep_ = 1; __VA_ARGS__ } }
#define QSLOT(L) ((L) + 4 * qrep_)
#define XBAR() xcd_barrier(bar, F.wave * 64 + (int)__builtin_amdgcn_mbcnt_hi(~0u, __builtin_amdgcn_mbcnt_lo(~0u, 0u)))
#define LAYER_BODY(L) { constexpr int pb = 2 + 7 * (L); constexpr bool GDN = ((L) & 1) != 0; \
        if ((L) != 0) { PDUP(-2, if (IN(pb)) { PHASE_FRAME(); p_norm(F, L); }) SEAM(pb); } \
        PDUP(3 + 4 * ((L) & 1) + 100 * ((L) >> 1), if (IN(pb + 1)) { PHASE_FRAME(); \
            pg8::Gemm g{F.h(), F.wt_in(L), MR, NIN, DM}; pg8::StaticOrder S; S.init(MR, NIN, F.G, F.bid); const EpiInProjV E = mk_epi_inproj_v(F, L); \
            pg8::gemm_phase<EpiInProjV, pg8::StaticOrder, true, true>(F.lds, g, S, E, F.tid); }) SEAM(pb + 1); \
        PDUP((GDN ? 8 : 4) + 100 * ((L) >> 1), if (IN(pb + 2)) { PHASE_FRAME(); if ((L) == 0) { pg8::Gemm g{F.hm(0), F.wt_mkv(0), 2048, 4096, DM}; MemKvOrder S{F.G, F.bid}; EpiMemKVV E{F.out()}; pg8::gemm_phase<EpiMemKVV, MemKvOrder, true, true>(F.lds, g, S, E, F.tid); } \
            if (GDN) GDN_PRE(F, L); else p_cumsum(F, L); }) SEAM(pb + 2); \
        if (GDN) { PDUP(9 + 100 * ((L) >> 1), if (IN(pb + 3)) { PHASE_FRAME(); GDN_SOLVE(F); }) SEAM(pb + 3); } \
        PDUP((GDN ? 10 : 5) + 100 * ((L) >> 1), if (IN(pb + 4)) { PHASE_FRAME(); if (GDN) GDN_SCAN(F, L); p_attention(F, L, QSLOT(L)); }) SEAM(pb + 4); \
        if (GDN) { PDUP(11 + 100 * ((L) >> 1), if (IN(pb + 5)) { PHASE_FRAME(); GDN_POST(F, L); }) SEAM(pb + 5); } \
        PDUP((L) == 0 ? 6 : -2, if (IN(pb + 6)) { PHASE_FRAME(); \
            pg8::Gemm g{(const bf16_t*)F.br(), F.wt_out(L), MR, DM, BRW}; OutProjOrder S; S.init(F.G, F.bid); EpiOutProjV E{L, F.out(), F.in(0), F.in(1), (float*)(F.ws() + WS_PART)}; \
            pg8::gemm_phase<EpiOutProjV, OutProjOrder, true, true>(F.lds, g, S, E, F.tid); }) SEAM(pb + 6); }
#if USE_GDN_CHUNK
#define GDN_PRE(F, L) gdn::p_gdn_pre(F, L)
#define GDN_SOLVE(F) gdn::p_gdn_solve(F)
#define GDN_SCAN(F, L) gdn::p_gdn_scan(F, L)
#define GDN_POST(F, L) gdn::p_gdn_post(F, L)
#else
#define GDN_PRE(F, L) do {} while (0)
#define GDN_SOLVE(F) do {} while (0)
#define GDN_SCAN(F, L) p_gdn_naive(F, L)
#define GDN_POST(F, L) do {} while (0)
#endif
    LAYER_BODY(0)
    LAYER_BODY(1)
    LAYER_BODY(2)
    LAYER_BODY(3)
    { if (IN(30)) { PHASE_FRAME(); p_final_norm(F); } }
#undef IN
#undef SEAM
}

extern "C" void kernel_launch(void* const* d_in, const int* in_sizes, int n_in, void* d_out, int out_size, void* d_ws, size_t ws_size, hipStream_t stream) {
    static int grid = 0;
    if (grid == 0) {
        if (n_in != 22 || (size_t)out_size != O_END || ws_size < WS_END_MIN) { fprintf(stderr, "kernel_launch: unexpected shapes n_in %d out %d ws %zu\n", n_in, out_size, ws_size); grid = -1; return; }
        int dev = 0, cus = 0;
        if (hipGetDevice(&dev) != hipSuccess || hipDeviceGetAttribute(&cus, hipDeviceAttributeMultiprocessorCount, dev) != hipSuccess) { grid = -1; return; }
        if (hipFuncSetAttribute((const void*)fwd, hipFuncAttributeMaxDynamicSharedMemorySize, LDS_BYTES) != hipSuccess) { fprintf(stderr, "kernel_launch: hipFuncSetAttribute failed\n"); grid = -1; return; }
        int per_cu = 0;
        if (hipOccupancyMaxActiveBlocksPerMultiprocessor(&per_cu, (const void*)fwd, NT, LDS_BYTES) != hipSuccess || per_cu < 1) { fprintf(stderr, "kernel_launch: occupancy query says %d\n", per_cu); }
        (void)hipGetLastError();
        grid = cus;
    }
    if (grid < 0) return;
    (void)hipMemsetAsync((char*)d_ws + WS_CTL, 0, CTL_ZERO_BYTES, stream);
    Args a{};
    for (int i = 0; i < 22; ++i) a.in[i] = (const float*)d_in[i];
    a.out = (float*)d_out; a.ws = (unsigned char*)d_ws;
#if defined(PROBE_PHASE)
    { const int cuts[4] = {0, PROBE_PHASE + 1, PROBE_PHASE + 1, NPH}; const int los[3] = {0, PROBE_PHASE, PROBE_PHASE + 1};
      for (int li = 0; li < 3; ++li) { a.ph_lo = los[li]; a.ph_hi = cuts[li + 1]; if (a.ph_lo >= a.ph_hi) continue;
          if (li) { (void)hipMemsetAsync((char*)d_ws + WS_CTL + CW_BAR * 4, 0, XCD_BAR_WORDS * 4, stream); (void)hipMemsetAsync((char*)d_ws + WS_CTL + CW_Q * 4, 0, 4096, stream); }
          hipLaunchKernelGGL(fwd, dim3(grid), dim3(NT), LDS_BYTES, stream, a); } }
#elif N_LAUNCHES == 1
    a.ph_lo = 0; a.ph_hi = NPH;
    hipLaunchKernelGGL(fwd, dim3(grid), dim3(NT), LDS_BYTES, stream, a);
#else
    for (int p = 0; p < NPH; ++p) {
        a.ph_lo = p; a.ph_hi = p + 1;
        hipLaunchKernelGGL(fwd, dim3(grid), dim3(NT), LDS_BYTES, stream, a);
    }
#endif
}
```
